# Optimizing an MI355X kernel written in HIP

```python
import jax
import jax.numpy as jnp
from jax import lax
import numpy as np


D_MODEL = 1024
BATCH = 32
SEQ = 2048
DEPTH = 1

D_MIX = D_MODEL
D_ATTN = D_MIX // 2
D_HGRN = D_MIX - D_ATTN
ATTN_HEAD_DIM = 64
N_ATTN_HEADS = D_ATTN // ATTN_HEAD_DIM
HGRN_EXPAND = 128
N_HGRN_HEADS = D_HGRN // HGRN_EXPAND
HGRN_VDIM = D_HGRN // N_HGRN_HEADS
D_FF = 128 * ((8 * D_MODEL // 3 + 127) // 128)
N_MOD = 9
Q_BLOCK = 128
HGRN_CHUNK = 64
FFN_RES = 0.5
EPS = 1e-6
IN_SIZES = (D_ATTN, D_ATTN, D_ATTN, N_ATTN_HEADS, D_HGRN, D_HGRN, D_HGRN, D_HGRN)
N_IN = sum(IN_SIZES)

kernel_name = "fox_hgrn2_macaron_adaln_hybrid"


def _rms(x, g):
    xf = x.astype(jnp.float32)
    y = xf * lax.rsqrt(jnp.mean(xf * xf, axis=-1, keepdims=True) + EPS)
    return (y * g.astype(jnp.float32)).astype(x.dtype)


def _modulate(x, g, shift, scale):
    return _rms(x, g) * (1 + scale[:, None, :]) + shift[:, None, :]


def _swiglu(h, w_in, w_out):
    gate, up = jnp.split(h @ w_in, 2, axis=-1)
    return (jax.nn.silu(gate) * up) @ w_out


def _forgetting_attention(q, k, v, fg_logit, q_g, k_g):
    B, S, H, Dh = q.shape
    q = _rms(q, q_g).transpose(0, 2, 1, 3)
    k = _rms(k, k_g).transpose(0, 2, 1, 3)
    v = v.transpose(0, 2, 1, 3)
    logf = jax.nn.log_sigmoid(fg_logit.astype(jnp.float32))
    F = jnp.cumsum(logf, axis=1).transpose(0, 2, 1)
    scale = Dh ** -0.5
    outs = []
    for blk in range(S // Q_BLOCK):
        q0 = blk * Q_BLOCK
        L = q0 + Q_BLOCK
        s = jnp.einsum('bhqd,bhkd->bhqk', q[:, :, q0:L], k[:, :, :L],
                       preferred_element_type=jnp.float32) * scale
        s = s + F[:, :, q0:L, None] - F[:, :, None, :L]
        qpos = q0 + jnp.arange(Q_BLOCK)
        kpos = jnp.arange(L)
        s = jnp.where(kpos[None, :] <= qpos[:, None], s, -jnp.inf)
        p = jax.nn.softmax(s, axis=-1)
        outs.append(jnp.einsum('bhqk,bhkd->bhqd', p.astype(v.dtype), v[:, :, :L]))
    o = jnp.concatenate(outs, axis=2)
    return o.transpose(0, 2, 1, 3).reshape(B, S, H * Dh)


def _hgrn2(q, f_logit, i, lb):
    B, S, H, K = q.shape
    V = i.shape[-1]
    z = f_logit.astype(jnp.float32)
    lbf = lb.astype(jnp.float32).reshape(H, K)
    logf = jnp.logaddexp(jnp.log(lbf), jnp.log1p(-lbf) + jax.nn.log_sigmoid(z))
    kk = (1 - lbf) * jax.nn.sigmoid(-z)
    qf = jax.nn.silu(q.astype(jnp.float32))
    C = HGRN_CHUNK
    NC = S // C

    def to_chunks(t):
        return t.reshape(B, NC, C, H, t.shape[-1]).transpose(1, 0, 3, 2, 4)

    xs = (to_chunks(qf), to_chunks(kk), to_chunks(i.astype(jnp.float32)), to_chunks(logf))
    causal = jnp.tril(jnp.ones((C, C), dtype=bool))

    def step(state, inp):
        qb, kb, vb, gb = inp
        b = jnp.cumsum(gb, axis=2)
        o_inter = jnp.einsum('bhck,bhkv->bhcv', qb * jnp.exp(b), state)
        diff = b[:, :, :, None, :] - b[:, :, None, :, :]
        decay = jnp.exp(jnp.where(causal[:, :, None], diff, -jnp.inf))
        A = jnp.einsum('bhtk,bhsk,bhtsk->bhts', qb, kb, decay)
        o_intra = jnp.einsum('bhts,bhsv->bhtv', A, vb)
        b_last = b[:, :, -1:, :]
        new_state = (jnp.exp(b_last[:, :, 0, :])[..., None] * state
                     + jnp.einsum('bhsk,bhsv->bhkv', kb * jnp.exp(b_last - b), vb))
        return new_state, o_inter + o_intra

    s0 = jnp.zeros((B, H, K, V), jnp.float32)
    _, o = lax.scan(step, s0, xs)
    return o.transpose(1, 0, 3, 2, 4).reshape(B, S, H, V).astype(q.dtype)


def _hybrid_mixer(h, w_in, b_fgate, q_g, k_g, attn_out_g, lb, hgrn_out_g, w_out):
    B, S, _ = h.shape
    proj = h @ w_in
    idx = np.cumsum(IN_SIZES)[:-1].tolist()
    qa, ka, va, fg, qh, fh, ih, gh = jnp.split(proj, idx, axis=-1)
    heads_a = lambda t: t.reshape(B, S, N_ATTN_HEADS, ATTN_HEAD_DIM)
    o_a = _forgetting_attention(heads_a(qa), heads_a(ka), heads_a(va), fg + b_fgate, q_g, k_g)
    o_a = _rms(o_a, attn_out_g)
    heads_k = lambda t: t.reshape(B, S, N_HGRN_HEADS, HGRN_EXPAND)
    o_h = _hgrn2(heads_k(qh), heads_k(fh), ih.reshape(B, S, N_HGRN_HEADS, HGRN_VDIM), lb)
    o_h = _rms(o_h, hgrn_out_g.reshape(N_HGRN_HEADS, HGRN_VDIM)).reshape(B, S, D_HGRN)
    o_h = o_h * jax.nn.silu(gh)
    return jnp.concatenate([o_a, o_h], axis=-1) @ w_out


def setup_inputs(seed: int = 0) -> dict:
    key = jax.random.key(seed)
    ks = jax.random.split(key, 24)
    f32 = jnp.float32
    nrm = lambda k, shape, s: s * jax.random.normal(k, shape, f32)
    L = DEPTH
    w_in_mix = jnp.concatenate([
        nrm(ks[9], (L, D_MODEL, 3 * D_ATTN), D_MODEL ** -0.5),
        nrm(ks[10], (L, D_MODEL, N_ATTN_HEADS), 0.1 * D_MODEL ** -0.5),
        nrm(ks[11], (L, D_MODEL, 4 * D_HGRN), D_MODEL ** -0.5)], axis=-1)
    return {
        'x': nrm(ks[0], (BATCH, SEQ, D_MODEL), 1.0),
        'c': nrm(ks[1], (BATCH, D_MODEL), 1.0),
        'w_ada': nrm(ks[2], (L, D_MODEL, N_MOD * D_MODEL), 0.5 * D_MODEL ** -0.5),
        'b_ada': nrm(ks[3], (L, N_MOD * D_MODEL), 0.02),
        'g_norm1': 1 + nrm(ks[4], (L, D_MODEL), 0.02),
        'ffn1_w_in': nrm(ks[5], (L, D_MODEL, 2 * D_FF), D_MODEL ** -0.5),
        'ffn1_w_out': nrm(ks[6], (L, D_FF, D_MODEL), D_FF ** -0.5),
        'g_norm_mix': 1 + nrm(ks[7], (L, D_MODEL), 0.02),
        'w_in_mix': w_in_mix,
        'b_fgate': jax.random.uniform(ks[12], (L, N_ATTN_HEADS), f32, 1.0, 4.0),
        'q_norm_g': 1 + nrm(ks[13], (L, ATTN_HEAD_DIM), 0.02),
        'k_norm_g': 1 + nrm(ks[14], (L, ATTN_HEAD_DIM), 0.02),
        'attn_out_g': 1 + nrm(ks[15], (L, D_ATTN), 0.02),
        'hgrn_lb_logits': nrm(ks[16], (DEPTH + 1, D_HGRN), 0.1),
        'hgrn_out_g': 1 + nrm(ks[17], (L, D_HGRN), 0.02),
        'w_out_mix': nrm(ks[18], (L, D_MIX, D_MODEL), D_MIX ** -0.5),
        'g_norm2': 1 + nrm(ks[19], (L, D_MODEL), 0.02),
        'ffn2_w_in': nrm(ks[20], (L, D_MODEL, 2 * D_FF), D_MODEL ** -0.5),
        'ffn2_w_out': nrm(ks[21], (L, D_FF, D_MODEL), D_FF ** -0.5),
    }


def reference(x, c, w_ada, b_ada, g_norm1, ffn1_w_in, ffn1_w_out, g_norm_mix, w_in_mix,
              b_fgate, q_norm_g, k_norm_g, attn_out_g, hgrn_lb_logits, hgrn_out_g,
              w_out_mix, g_norm2, ffn2_w_in, ffn2_w_out):
    lb_all = jnp.cumsum(jax.nn.softmax(hgrn_lb_logits.astype(jnp.float32), axis=0), axis=0)
    cs = jax.nn.silu(c)
    for l in range(DEPTH):
        mod = cs @ w_ada[l] + b_ada[l]
        sh1, sc1, gt1, shm, scm, gtm, sh2, sc2, gt2 = jnp.split(mod, N_MOD, axis=-1)
        h = _modulate(x, g_norm1[l], sh1, sc1)
        x = x + FFN_RES * gt1[:, None, :] * _swiglu(h, ffn1_w_in[l], ffn1_w_out[l])
        h = _modulate(x, g_norm_mix[l], shm, scm)
        x = x + gtm[:, None, :] * _hybrid_mixer(h, w_in_mix[l], b_fgate[l], q_norm_g[l], k_norm_g[l],
                                                attn_out_g[l], lb_all[l], hgrn_out_g[l], w_out_mix[l])
        h = _modulate(x, g_norm2[l], sh2, sc2)
        x = x + FFN_RES * gt2[:, None, :] * _swiglu(h, ffn2_w_in[l], ffn2_w_out[l])
    return x
```

```cpp
#include <hip/hip_runtime.h>
#include <hip/hip_cooperative_groups.h>
#include <cstdio>
#include <cstdint>
namespace cg = cooperative_groups;
namespace pg8 {
#define PG8_LAS __attribute__((address_space(3)))
typedef unsigned short bf16_t;
typedef short bf16x8 __attribute__((ext_vector_type(8)));
typedef float f32x4 __attribute__((ext_vector_type(4)));
typedef unsigned u32x4 __attribute__((ext_vector_type(4)));
constexpr int BM = 256, BK = 64, HALF = 128, HTB = HALF * BK * 2  , STAGE_BYTES = 8 * HTB, NXCD = 8, WGM = 8;

__host__ __device__ __forceinline__ int lds_byte(int r, int c) { const int st = (r >> 4) * 2 + (c >> 5), rr = r & 15, cc = c & 31, ob = rr * 64 + cc * 2; return st * 1024 + (ob ^ (((ob >> 9) & 1) << 5)); }
__host__ __device__ __forceinline__ void stage_rc(int b, int& R, int& C) { const int st = b / 1024, sb = b % 1024, swz = sb ^ (((sb >> 9) & 1) << 5); R = (st >> 1) * 16 + swz / 64; C = (st & 1) * 32 + (swz % 64) / 2; }
__host__ __device__ __forceinline__ int perm32(int rho) { const int n = rho >> 4, i = rho & 15; return 8 * (i >> 2) + 4 * n + (i & 3); }

struct Unit { int pm, pn; };
struct Gemm { const bf16_t* A; const bf16_t* Bt; int M, N, K; };

struct StaticOrder {
    int nM, nN, nwg, G, c;
    __host__ __device__ void init(int M, int N, int G_, int c_) { nM = M / BM; nN = N / BM; nwg = nM * nN; G = G_; c = c_; }
    __host__ __device__ bool next(int i, Unit& u) const {
        const long L = (long)i * G + c; if (L >= nwg) return false;
        int wgid = (int)L; { const int q = nwg / NXCD, r = nwg % NXCD, xcd = wgid % NXCD, off = wgid / NXCD; wgid = (xcd < r ? xcd * (q + 1) : r * (q + 1) + (xcd - r) * q) + off; }
        const int nig = WGM * nN, gid = wgid / nig, fm = gid * WGM, gsz = (nM - fm) < WGM ? (nM - fm) : WGM;
        u.pm = fm + ((wgid % nig) % gsz); u.pn = (wgid % nig) / gsz; return true;
    }
    __device__ __forceinline__ void a_ready(const Unit&) const {}
    __device__ __forceinline__ void done(const Unit&) const {}
};

__device__ __forceinline__ unsigned cvt_pk_bf16(float lo, float hi) { unsigned r; asm volatile("v_cvt_pk_bf16_f32 %0, %1, %2" : "=v"(r) : "v"(lo), "v"(hi)); return r; }
typedef float f32x2 __attribute__((ext_vector_type(2)));
__device__ __forceinline__ float silu_f(float x) { return x * __builtin_amdgcn_rcpf(1.0f + __expf(-x)); }
struct EpiSwiGLU {
    static constexpr bool PERM = true, AFTER_DRAIN = false, MID = false; static constexpr int MID_T = -1;
    bf16_t* O; int ldc;
    __device__ __forceinline__ void mid(f32x4 (&)[2][2][4][2], const Unit&, int, int) const {}
    __device__ __forceinline__ void operator()(const f32x4 (&acc)[2][2][4][2], const Unit& u, int wr, int wc, int fr, int fq) const {
        const int row0 = u.pm * BM + wr * 64 + fr, col0 = u.pn * 128 + wc * 32 + 8 * fq;
#pragma unroll
        for (int ai = 0; ai < 2; ++ai)
#pragma unroll
            for (int m = 0; m < 4; ++m) { bf16_t* p = O + (size_t)(row0 + ai * HALF + m * 16) * ldc + col0;
                const f32x4 g0 = acc[ai][0][m][0], g1 = acc[ai][0][m][1], u0 = acc[ai][1][m][0], u1 = acc[ai][1][m][1];
                u32x4 w; w.x = cvt_pk_bf16(silu_f(g0[0]) * u0[0], silu_f(g0[1]) * u0[1]); w.y = cvt_pk_bf16(silu_f(g0[2]) * u0[2], silu_f(g0[3]) * u0[3]);
                w.z = cvt_pk_bf16(silu_f(g1[0]) * u1[0], silu_f(g1[1]) * u1[1]); w.w = cvt_pk_bf16(silu_f(g1[2]) * u1[2], silu_f(g1[3]) * u1[3]);
                *(u32x4*)p = w; }
    }
};
template <bool MIDF> struct EpiResid {
    static constexpr bool PERM = true, AFTER_DRAIN = false, MID = MIDF; static constexpr int MID_T = 8;
    const float* base; float* out; const float* gate; float coef; const float* ssq;
    __device__ __forceinline__ void mid(f32x4 (&acc)[2][2][4][2], const Unit& u, int wr, int fr) const {
#pragma unroll
        for (int ai = 0; ai < 2; ++ai)
#pragma unroll
            for (int m = 0; m < 4; ++m) { const size_t row = (size_t)(u.pm * BM + ai * HALF + wr * 64 + m * 16 + fr);
                const f32x4 a = *(const f32x4*)(ssq + row * 8), b = *(const f32x4*)(ssq + row * 8 + 4);
                const float s = ((a[0] + a[1]) + (a[2] + a[3])) + ((b[0] + b[1]) + (b[2] + b[3]));
                const float rs = 1.0f / sqrtf(s * (1.0f / 512.0f) + 1e-6f);
#pragma unroll
                for (int bj = 0; bj < 2; ++bj)
#pragma unroll
                    for (int n = 0; n < 2; ++n) acc[ai][bj][m][n] = acc[ai][bj][m][n] * rs; }
    }
    __device__ __forceinline__ void operator()(const f32x4 (&acc)[2][2][4][2], const Unit& u, int wr, int wc, int fr, int fq) const {
        const int b = u.pm >> 3; const float* gp = gate + (size_t)b * 9216; const int col0 = u.pn * BM + wc * 32 + 8 * fq;
        f32x4 gv[2][2];
#pragma unroll
        for (int bj = 0; bj < 2; ++bj)
#pragma unroll
            for (int n = 0; n < 2; ++n) gv[bj][n] = *(const f32x4*)(gp + col0 + bj * HALF + n * 4) * coef;
#pragma unroll
        for (int ai = 0; ai < 2; ++ai)
#pragma unroll
            for (int m = 0; m < 4; ++m) { const size_t off = (size_t)(u.pm * BM + ai * HALF + wr * 64 + m * 16 + fr) * 1024 + col0;
#pragma unroll
                for (int bj = 0; bj < 2; ++bj)
#pragma unroll
                    for (int n = 0; n < 2; ++n) { const f32x4 bs = *(const f32x4*)(base + off + bj * HALF + n * 4); *(f32x4*)(out + off + bj * HALF + n * 4) = bs + gv[bj][n] * acc[ai][bj][m][n]; }
                if (m & 1) asm volatile("" ::: "memory"); }
    }
};
struct EpiMix {
    static constexpr bool PERM = true, AFTER_DRAIN = false, MID = false; static constexpr int MID_T = -1;
    bf16_t* P; size_t segstride; const float* qg; const float* kg; const float* lbl; float c2;
    __device__ __forceinline__ void mid(f32x4 (&)[2][2][4][2], const Unit&, int, int) const {}
    __device__ __forceinline__ void operator()(const f32x4 (&acc)[2][2][4][2], const Unit& u, int wr, int wc, int fr, int fq) const {
        const int seg = u.pn >> 1, half = u.pn & 1;
        bf16_t* base = P + (size_t)seg * segstride + (size_t)(u.pm * BM + wr * 64 + fr) * 512 + 256 * half;
        if (seg < 2) {
            const float* g = seg == 0 ? qg : kg; const float sc = seg == 0 ? c2 : 1.0f;
            f32x4 gn[2][2];
#pragma unroll
            for (int bj = 0; bj < 2; ++bj)
#pragma unroll
                for (int n = 0; n < 2; ++n) gn[bj][n] = *(const f32x4*)(g + 32 * bj + 8 * fq + 4 * n) * sc;
#pragma unroll
            for (int ai = 0; ai < 2; ++ai)
#pragma unroll
                for (int m = 0; m < 4; ++m) { float ss = 0.f;
#pragma unroll
                    for (int bj = 0; bj < 2; ++bj)
#pragma unroll
                        for (int n = 0; n < 2; ++n) { const f32x4 x = acc[ai][bj][m][n]; ss += (x[0] * x[0] + x[1] * x[1]) + (x[2] * x[2] + x[3] * x[3]); }
                    ss += __shfl_xor(ss, 16); ss += __shfl_xor(ss, 32);
                    const float rs = 1.0f / sqrtf(ss * (1.0f / 64.0f) + 1e-6f);
#pragma unroll
                    for (int bj = 0; bj < 2; ++bj) { const f32x4 v0 = acc[ai][bj][m][0] * gn[bj][0] * rs, v1 = acc[ai][bj][m][1] * gn[bj][1] * rs;
                        u32x4 w; w.x = cvt_pk_bf16(v0[0], v0[1]); w.y = cvt_pk_bf16(v0[2], v0[3]); w.z = cvt_pk_bf16(v1[0], v1[1]); w.w = cvt_pk_bf16(v1[2], v1[3]);
                        *(u32x4*)(base + (size_t)(ai * HALF + m * 16) * 512 + 64 * wc + 32 * bj + 8 * fq) = w; } }
        } else {
            const int cw = wc * 32 + 8 * fq;
            f32x4 om[2][2];
#pragma unroll
            for (int bj = 0; bj < 2; ++bj)
#pragma unroll
                for (int n = 0; n < 2; ++n) { om[bj][n] = (f32x4){1.f, 1.f, 1.f, 1.f};
                    if (seg == 4) { const int c = 256 * half + 128 * bj + cw + 4 * n; const f32x4 l0 = *(const f32x4*)(lbl + c), l1 = *(const f32x4*)(lbl + 512 + c);
#pragma unroll
                        for (int e = 0; e < 4; ++e) om[bj][n][e] = __builtin_amdgcn_rcpf(1.0f + __expf(l0[e] - l1[e])); } }
#pragma unroll
            for (int ai = 0; ai < 2; ++ai)
#pragma unroll
                for (int m = 0; m < 4; ++m)
#pragma unroll
                    for (int bj = 0; bj < 2; ++bj) { f32x4 v0 = acc[ai][bj][m][0], v1 = acc[ai][bj][m][1];
                        if (seg == 3 || seg == 6) {
#pragma unroll
                            for (int e = 0; e < 4; ++e) { v0[e] = silu_f(v0[e]); v1[e] = silu_f(v1[e]); }
                        } else if (seg == 4) {
#pragma unroll
                            for (int e = 0; e < 4; ++e) { v0[e] = om[bj][0][e] * __builtin_amdgcn_rcpf(1.0f + __expf(v0[e])); v1[e] = om[bj][1][e] * __builtin_amdgcn_rcpf(1.0f + __expf(v1[e])); }
                        }
                        u32x4 w; w.x = cvt_pk_bf16(v0[0], v0[1]); w.y = cvt_pk_bf16(v0[2], v0[3]); w.z = cvt_pk_bf16(v1[0], v1[1]); w.w = cvt_pk_bf16(v1[2], v1[3]);
                        *(u32x4*)(base + (size_t)(ai * HALF + m * 16) * 512 + 128 * bj + cw) = w; }
        }
    }
};
template <class Epi, class Sched, bool ALIGN_EPI = false, bool SP2 = false>
__device__ __forceinline__ void gemm_phase(PG8_LAS unsigned char* lds, const Gemm g, const Sched& S, const Epi& E) {
    int tid_ = threadIdx.x; asm volatile("" : "+v"(tid_));
    const int tid = tid_, wid = __builtin_amdgcn_readfirstlane(tid >> 6), lane = tid & 63, wr = wid >> 2, wc = wid & 3, fr = lane & 15, fq = lane >> 4;
    const int K = g.K, nt = K / BK;
    unsigned voffA[2], voffB[2];
#pragma unroll
    for (int i = 0; i < 2; ++i) { int R, C; stage_rc(tid * 16 + i * 8192, R, C); const int Rb = Epi::PERM ? ((R & ~31) + perm32(R & 31)) : R;
        voffA[i] = (unsigned)(R * K + C) * 2u; voffB[i] = (unsigned)(Rb * K + C) * 2u; }
    const size_t kstep = (size_t)(BK * 2);
    const size_t hstep = (size_t)HALF * K * 2;
    const size_t tstep = 2 * hstep;
    const unsigned ldsw = (unsigned)wid * 1024u;
    const int aoff = lds_byte(wr * 64 + fr, fq * 8), boff = lds_byte(wc * 32 + fr, fq * 8);
#define PG8_SA(b, h) (((b) * 2 + (h)) * HTB)
#define PG8_SB(b, h) ((4 + (b) * 2 + (h)) * HTB)
#define PG8_STAGE(bufoff, gbase, voff) do { _Pragma("unroll") for (int _i = 0; _i < 2; ++_i) \
        __builtin_amdgcn_global_load_lds((const unsigned*)((const char*)(gbase) + (voff)[_i]), (PG8_LAS unsigned*)(lds + (bufoff) + ldsw + _i * 8192), 16, 0, 0); } while (0)
#define PG8_LDA(dst, b, h) do { _Pragma("unroll") for (int m = 0; m < 4; ++m) _Pragma("unroll") for (int k = 0; k < 2; ++k) dst[m][k] = *(const PG8_LAS bf16x8*)(lds + PG8_SA(b, h) + aoff + m * 2048 + k * 1024); } while (0)
#define PG8_LDB(dst, b, h) do { _Pragma("unroll") for (int n = 0; n < 2; ++n) _Pragma("unroll") for (int k = 0; k < 2; ++k) dst[n][k] = *(const PG8_LAS bf16x8*)(lds + PG8_SB(b, h) + boff + n * 2048 + k * 1024); } while (0)
#define PG8_MMA(ai, bj, At, Bt) do { __builtin_amdgcn_s_setprio(1); _Pragma("unroll") for (int m = 0; m < 4; ++m) _Pragma("unroll") for (int n = 0; n < 2; ++n) _Pragma("unroll") for (int k = 0; k < 2; ++k) \
        acc[ai][bj][m][n] = __builtin_amdgcn_mfma_f32_16x16x32_bf16(Bt[n][k], At[m][k], acc[ai][bj][m][n], 0, 0, 0); __builtin_amdgcn_s_setprio(0); } while (0)
#define PG8_WAIT_V(n) asm volatile("s_waitcnt vmcnt(" #n ")" ::: "memory")
#define PG8_WAIT_L(n) asm volatile("s_waitcnt lgkmcnt(" #n ")" ::: "memory")
#define PG8_BAR __builtin_amdgcn_s_barrier()
#define PG8_SCHED __builtin_amdgcn_sched_barrier(0)
    Unit cur, nxt; int ui = 0;
    if (!S.next(0, cur)) return;
    f32x4 acc[2][2][4][2];
#pragma unroll
    for (int a = 0; a < 2; ++a)
#pragma unroll
        for (int b = 0; b < 2; ++b)
#pragma unroll
            for (int m = 0; m < 4; ++m)
#pragma unroll
                for (int n = 0; n < 2; ++n) acc[a][b][m][n] = (f32x4){0.f, 0.f, 0.f, 0.f};
    bf16x8 At[4][2], B0[2][2], B1[2][2];
    const char* cA = (const char*)g.A + (size_t)cur.pm * tstep; const char* cB = (const char*)g.Bt + (size_t)cur.pn * tstep;
    S.a_ready(cur);
    if constexpr (SP2) {
        PG8_STAGE(PG8_SB(0, 0), cB, voffB); PG8_STAGE(PG8_SB(0, 1), cB + hstep, voffB); PG8_STAGE(PG8_SA(0, 0), cA, voffA); PG8_STAGE(PG8_SA(0, 1), cA + hstep, voffA);
        if (wr == 1) PG8_BAR;
        PG8_WAIT_V(2); PG8_BAR;
        PG8_STAGE(PG8_SB(1, 0), cB + kstep, voffB); PG8_STAGE(PG8_SA(1, 0), cA + kstep, voffA); PG8_STAGE(PG8_SB(1, 1), cB + hstep + kstep, voffB);
        PG8_WAIT_V(6); PG8_BAR;
    } else {
        PG8_STAGE(PG8_SB(0, 0), cB, voffB); PG8_STAGE(PG8_SA(0, 0), cA, voffA); PG8_STAGE(PG8_SB(0, 1), cB + hstep, voffB); PG8_STAGE(PG8_SA(0, 1), cA + hstep, voffA);
        if (wr == 1) PG8_BAR;
        PG8_WAIT_V(4); PG8_BAR;
        PG8_STAGE(PG8_SB(1, 0), cB + kstep, voffB); PG8_STAGE(PG8_SA(1, 0), cA + kstep, voffA); PG8_STAGE(PG8_SB(1, 1), cB + hstep + kstep, voffB);
        PG8_WAIT_V(6); PG8_BAR;
    }
    for (;;) {
        const bool has_next = S.next(ui + 1, nxt);
        const char* nA = has_next ? (const char*)g.A + (size_t)nxt.pm * tstep : cA; const char* nB = has_next ? (const char*)g.Bt + (size_t)nxt.pn * tstep : cB;
        for (int t = 0; t < nt; t += 2) {
            if constexpr (Epi::MID) { if (t == Epi::MID_T) E.mid(acc, cur, wr, fr); }
            const bool last = (t == nt - 2);
            const char* a1 = cA + (size_t)(t + 1) * kstep;
            const char* a2 = last ? nA : cA + (size_t)(t + 2) * kstep; const char* b2 = last ? nB : cB + (size_t)(t + 2) * kstep;
            const char* a3 = a2 + kstep; const char* b3 = b2 + kstep;
            if (last && has_next) S.a_ready(nxt);
            if constexpr (SP2) {
            PG8_LDB(B0, 0, 0); PG8_LDB(B1, 0, 1); PG8_SCHED; PG8_LDA(At, 0, 0); PG8_STAGE(PG8_SA(1, 1), a1 + hstep, voffA);
            PG8_WAIT_V(8); PG8_WAIT_L(0); PG8_BAR; PG8_MMA(0, 0, At, B0); PG8_MMA(0, 1, At, B1); PG8_BAR; PG8_SCHED;
            PG8_LDA(At, 0, 1); PG8_STAGE(PG8_SB(0, 0), b2, voffB); PG8_STAGE(PG8_SB(0, 1), b2 + hstep, voffB); PG8_STAGE(PG8_SA(0, 0), a2, voffA);
            PG8_WAIT_V(8); PG8_WAIT_L(0); PG8_BAR; PG8_MMA(1, 0, At, B0); PG8_MMA(1, 1, At, B1); PG8_BAR; PG8_SCHED;
            PG8_LDB(B0, 1, 0); PG8_LDB(B1, 1, 1); PG8_SCHED; PG8_LDA(At, 1, 0); PG8_STAGE(PG8_SA(0, 1), a2 + hstep, voffA);
            PG8_WAIT_V(8); PG8_WAIT_L(0); PG8_BAR; PG8_MMA(0, 0, At, B0); PG8_MMA(0, 1, At, B1); PG8_BAR; PG8_SCHED;
            PG8_LDA(At, 1, 1); PG8_STAGE(PG8_SB(1, 0), b3, voffB); PG8_STAGE(PG8_SB(1, 1), b3 + hstep, voffB); PG8_STAGE(PG8_SA(1, 0), a3, voffA);
            PG8_WAIT_V(8); PG8_WAIT_L(0); PG8_BAR; PG8_MMA(1, 0, At, B0); PG8_MMA(1, 1, At, B1); PG8_BAR; PG8_SCHED;
            } else {
            PG8_LDB(B0, 0, 0); PG8_SCHED; PG8_LDA(At, 0, 0); PG8_STAGE(PG8_SA(1, 1), a1 + hstep, voffA);
            PG8_WAIT_L(8); PG8_BAR; PG8_WAIT_L(0); PG8_MMA(0, 0, At, B0); PG8_BAR; PG8_SCHED;
            PG8_LDB(B1, 0, 1); PG8_STAGE(PG8_SB(0, 0), b2, voffB);
            PG8_BAR; PG8_WAIT_L(0); PG8_MMA(0, 1, At, B1); PG8_BAR;
            PG8_LDA(At, 0, 1); PG8_STAGE(PG8_SA(0, 0), a2, voffA);
            PG8_BAR; PG8_WAIT_L(0); PG8_MMA(1, 0, At, B0); PG8_BAR; PG8_SCHED;
            PG8_STAGE(PG8_SB(0, 1), b2 + hstep, voffB);
            PG8_WAIT_V(6); PG8_BAR; PG8_MMA(1, 1, At, B1); PG8_BAR;
            PG8_LDB(B0, 1, 0); PG8_SCHED; PG8_LDA(At, 1, 0); PG8_STAGE(PG8_SA(0, 1), a2 + hstep, voffA);
            PG8_WAIT_L(8); PG8_BAR; PG8_WAIT_L(0); PG8_MMA(0, 0, At, B0); PG8_BAR; PG8_SCHED;
            PG8_LDB(B1, 1, 1); PG8_STAGE(PG8_SB(1, 0), b3, voffB);
            PG8_BAR; PG8_WAIT_L(0); PG8_MMA(0, 1, At, B1); PG8_BAR;
            PG8_LDA(At, 1, 1); PG8_STAGE(PG8_SA(1, 0), a3, voffA);
            PG8_BAR; PG8_WAIT_L(0); PG8_MMA(1, 0, At, B0); PG8_BAR; PG8_SCHED;
            PG8_STAGE(PG8_SB(1, 1), b3 + hstep, voffB);
            PG8_WAIT_V(6); PG8_BAR; PG8_MMA(1, 1, At, B1); PG8_BAR;
            }
        }
        if constexpr (ALIGN_EPI) { if (wr == 0) PG8_BAR; }
        if constexpr (!Epi::AFTER_DRAIN) { E(acc, cur, wr, wc, fr, fq); S.done(cur); }
        if (!has_next) break;
#pragma unroll
        for (int a = 0; a < 2; ++a)
#pragma unroll
            for (int b = 0; b < 2; ++b)
#pragma unroll
                for (int m = 0; m < 4; ++m)
#pragma unroll
                    for (int n = 0; n < 2; ++n) acc[a][b][m][n] = (f32x4){0.f, 0.f, 0.f, 0.f};
        cur = nxt; cA = nA; cB = nB; ++ui;
        if constexpr (ALIGN_EPI) { if (wr == 1) PG8_BAR; }
    }
    PG8_WAIT_V(0);
    if constexpr (!ALIGN_EPI) { if (wr == 0) PG8_BAR; }
    PG8_BAR;
    if constexpr (Epi::AFTER_DRAIN) { E.fused(acc, cur, wr, wc, fr, fq, lds, wid, lane); S.done(cur); }
#undef PG8_SA
#undef PG8_SB
#undef PG8_STAGE
#undef PG8_LDA
#undef PG8_LDB
#undef PG8_MMA
#undef PG8_WAIT_V
#undef PG8_WAIT_L
#undef PG8_BAR
#undef PG8_SCHED
}
}
#include <hip/hip_bf16.h>
#include <cmath>
namespace attn_body {
using bf16=__hip_bfloat16;
using bf16x8=__attribute__((ext_vector_type(8)))short;
using s16x4=__attribute__((ext_vector_type(4)))short;
using f32x16=__attribute__((ext_vector_type(16)))float;
using u32x4=__attribute__((ext_vector_type(4)))unsigned;
constexpr int BATCH=32,NHEAD=8,SEQ=2048,D=64,DM=512,OPITCH=1024;
constexpr int NW=8,QBLK=32,QB=QBLK*NW,KVBLK=64,NQB=SEQ/QB;
constexpr int ATTN_PITCH=DM, ATTN_UNIT_ROWS=QB;
__device__ __forceinline__ int crow(int r,int hi){return (r&3)+8*(r>>2)+4*hi;}
#define SBAR() __builtin_amdgcn_sched_barrier(0)
__device__ __forceinline__ void cmask(f32x16&p0,f32x16&p1,int jb,int qrel,int hi){
  const float NEG=-INFINITY; int kb=64*jb+4*hi;
  #pragma unroll
  for(int r=0;r<16;++r){int kv=kb+(r&3)+8*(r>>2); if(kv>qrel)p0[r]=NEG; if(kv+32>qrel)p1[r]=NEG;}
}

constexpr int NSLOT=3, SLOTB=8192;
constexpr int LDS_K=0, LDS_V=NSLOT*SLOTB, LDS_WS=2*NSLOT*SLOTB, LDS_OST=LDS_WS+NW*64*4, LDS_KA=LDS_OST+NW*4096,LDS_BYTES=LDS_KA+SEQ*16;
constexpr float C2=0.125f*1.4426950408889634f;
__device__ __forceinline__ void glds16(const void*gsrc,unsigned lds_dst){unsigned keep;
  asm volatile("s_mov_b32 %0, m0\n\ts_mov_b32 m0, %2\n\ts_nop 0\n\tglobal_load_lds_dwordx4 %1, off\n\ts_mov_b32 m0, %0":"=&s"(keep):"v"(gsrc),"s"(lds_dst):"memory");}
__device__ __forceinline__ float max3f(float a,float b,float c){float r;asm("v_max3_f32 %0, %1, %2, %3":"=v"(r):"v"(a),"v"(b),"v"(c));return r;}
__device__ __forceinline__ float max2f(float a,float b){float r;asm("v_max_f32_e32 %0, %1, %2":"=v"(r):"v"(a),"v"(b));return r;}
__device__ __forceinline__ float fadd_s(float a,float b){float r;asm("v_add_f32_e32 %0, %1, %2":"=v"(r):"v"(a),"v"(b));return r;}
__device__ __forceinline__ float fsub_s(float a,float b){float r;asm("v_sub_f32_e32 %0, %1, %2":"=v"(r):"v"(a),"v"(b));return r;}
typedef float f32x2_t __attribute__((ext_vector_type(2))); typedef __bf16 bf16x2_t __attribute__((ext_vector_type(2)));
__device__ __forceinline__ unsigned cvtpk_s(float lo,float hi){f32x2_t v={lo,hi};bf16x2_t b=__builtin_convertvector(v,bf16x2_t);return __builtin_bit_cast(unsigned,b);}
#define WAIT_BAR(N) asm volatile("s_waitcnt vmcnt(" #N ") lgkmcnt(0)\n\ts_barrier":::"memory")

__device__ __forceinline__ void qkt(f32x16&p0,f32x16&p1,const char*Kslot,const bf16x8*qr,const f32x16&negm,int r32,int hi,const bf16x8&ka0,const bf16x8&ka1,const bf16x8&qa){
  const char*kb=Kslot+hi*1024+r32*16;
  #pragma unroll
  for(int d0=0;d0<4;++d0){
    const bf16x8 b0=*reinterpret_cast<const bf16x8*>(kb+d0*2048);
    const bf16x8 b1=*reinterpret_cast<const bf16x8*>(kb+d0*2048+512);
    if(d0==0){p0=__builtin_amdgcn_mfma_f32_32x32x16_bf16(b0,qr[0],negm,0,0,0);p1=__builtin_amdgcn_mfma_f32_32x32x16_bf16(b1,qr[0],negm,0,0,0);}
    else{p0=__builtin_amdgcn_mfma_f32_32x32x16_bf16(b0,qr[d0],p0,0,0,0);p1=__builtin_amdgcn_mfma_f32_32x32x16_bf16(b1,qr[d0],p1,0,0,0);}}
  p0=__builtin_amdgcn_mfma_f32_32x32x16_bf16(ka0,qa,p0,0,0,0);p1=__builtin_amdgcn_mfma_f32_32x32x16_bf16(ka1,qa,p1,0,0,0);
}
typedef __attribute__((address_space(3))) const char* lds_cptr;
typedef short v4i16_t __attribute__((ext_vector_type(4)));
__device__ __forceinline__ void kload8(bf16x8*kf,lds_cptr kp){
  kf[0]=*(const __attribute__((address_space(3))) bf16x8*)(kp);      kf[1]=*(const __attribute__((address_space(3))) bf16x8*)(kp+512);
  kf[2]=*(const __attribute__((address_space(3))) bf16x8*)(kp+2048); kf[3]=*(const __attribute__((address_space(3))) bf16x8*)(kp+2560);
  kf[4]=*(const __attribute__((address_space(3))) bf16x8*)(kp+4096); kf[5]=*(const __attribute__((address_space(3))) bf16x8*)(kp+4608);
  kf[6]=*(const __attribute__((address_space(3))) bf16x8*)(kp+6144); kf[7]=*(const __attribute__((address_space(3))) bf16x8*)(kp+6656);
}
__device__ __forceinline__ void kload2(bf16x8*kf,lds_cptr kp,int j){ kf[2*j]=*(const __attribute__((address_space(3))) bf16x8*)(kp+j*2048); kf[2*j+1]=*(const __attribute__((address_space(3))) bf16x8*)(kp+j*2048+512); }
__device__ __forceinline__ s16x4 vtr(lds_cptr p){ return __builtin_bit_cast(s16x4,__builtin_amdgcn_ds_read_tr16_b64_v4i16((__attribute__((address_space(3))) v4i16_t*)p)); }
__device__ __forceinline__ float rowmax(const f32x16&p0,const f32x16&p1){
  float a=max3f(p0[0],p0[1],p1[0]),b=max3f(p0[2],p0[3],p1[1]);a=max3f(a,p1[2],p1[3]);
  #pragma unroll
  for(int r=4;r<16;r+=4){a=max3f(a,p0[r],p0[r+1]);b=max3f(b,p0[r+2],p0[r+3]);a=max3f(a,p1[r],p1[r+1]);b=max3f(b,p1[r+2],p1[r+3]);}
  const float m=max2f(a,b);
  auto rr=__builtin_amdgcn_permlane32_swap(__float_as_uint(m),__float_as_uint(m),false,false);
  return max2f(__uint_as_float(rr[0]),__uint_as_float(rr[1]));
}
__device__ __forceinline__ void pv(f32x16*o,int vb,bf16x8 pa0,bf16x8 pa1,bf16x8 pa2,bf16x8 pa3){
  #pragma unroll
  for(int d0=0;d0<2;++d0){s16x4 lo[4],hi[4];
    #pragma unroll
    for(int ks=0;ks<4;++ks){
      asm volatile("ds_read_b64_tr_b16 %0,%1 offset:%c2":"=&v"(lo[ks]):"v"(vb),"i"(d0*4096+ks*1024):"memory");
      asm volatile("ds_read_b64_tr_b16 %0,%1 offset:%c2":"=&v"(hi[ks]):"v"(vb),"i"(d0*4096+ks*1024+512):"memory");}
    asm volatile("s_waitcnt lgkmcnt(0)":::"memory");SBAR();
    #define PK(k) (bf16x8){lo[k][0],lo[k][1],lo[k][2],lo[k][3],hi[k][0],hi[k][1],hi[k][2],hi[k][3]}
    o[d0]=__builtin_amdgcn_mfma_f32_32x32x16_bf16(pa0,PK(0),o[d0],0,0,0);
    o[d0]=__builtin_amdgcn_mfma_f32_32x32x16_bf16(pa1,PK(1),o[d0],0,0,0);
    o[d0]=__builtin_amdgcn_mfma_f32_32x32x16_bf16(pa2,PK(2),o[d0],0,0,0);
    o[d0]=__builtin_amdgcn_mfma_f32_32x32x16_bf16(pa3,PK(3),o[d0],0,0,0);
    #undef PK
  }
}

#ifndef ATTN_STORE16
#define ATTN_STORE16(p,v) (*(u32x4*)(p)=(v))
#endif
template<int THRL,bool COPYF> __device__ __forceinline__ void attn_unit(int b,int h,int qb,const bf16*Q,const bf16*__restrict__ K,const bf16*__restrict__ V,bf16*O,const float*__restrict__ Fg,float*__restrict__ ssq,char*shm){
  int tid_=threadIdx.x; asm volatile("":"+v"(tid_)); const int tid=tid_,lane=tid&63,r32=lane&31,hi=lane>>5; const int wid=__builtin_amdgcn_readfirstlane(tid>>6);
  const long rowbase=(long)b*SEQ; const int q0=qb*QB;
  const bf16*Qw=Q+(rowbase+q0+wid*QBLK)*DM+h*D;
  const bf16*Kh=K+rowbase*DM+h*D,*Vh=V+rowbase*DM+h*D;
  const lds_cptr shm3=(lds_cptr)shm;
  const unsigned lds0=(unsigned)(uintptr_t)shm;
  float*wsf=(float*)(shm+LDS_WS)+wid*64;
  const bf16*ksrc=Kh+(long)lane*DM+wid*8;
  const bf16*vsrc=Vh+(long)(16*(wid&3)+(lane>>2))*DM+(wid>>2)*32+(lane&3)*8;
  const unsigned kdst=lds0+LDS_K+wid*1024, vdst=lds0+LDS_V+wid*1024;
  #define DMA_K(t,slot) glds16(ksrc+(long)(t)*KVBLK*DM,(unsigned)__builtin_amdgcn_readfirstlane(kdst+(slot)))
  #define DMA_V(t,slot) glds16(vsrc+(long)(t)*KVBLK*DM,(unsigned)__builtin_amdgcn_readfirstlane(vdst+(slot)))
  const int vb0=(int)(lds0+LDS_V)+((lane>>4)&1)*32+(lane&3)*8+(4*hi+((lane&15)>>2))*64;
  const char*Kbase=shm+LDS_K; bf16x8 kf[8];
  const lds_cptr kp0=shm3+LDS_K+hi*1024+r32*16; const lds_cptr vp0=shm3+LDS_V+((lane>>4)&1)*32+(lane&3)*8+(4*hi+((lane&15)>>2))*64;
  const int NT=(q0+QB)/KVBLK;
  typedef float f32x4_t __attribute__((ext_vector_type(4))); typedef __attribute__((address_space(3))) u32x4 lds_u4; typedef __attribute__((address_space(3))) const bf16x8 lds_cfrag;
  f32x4_t fv_=f32x4_t{}; const bool docp_=COPYF&&(tid*4<q0+QB); if(docp_)fv_=*reinterpret_cast<const f32x4_t*>(Fg+tid*4);
  const float gq_=Fg[q0+wid*QBLK+r32];
  DMA_K(0,0);DMA_V(0,0);DMA_K(1,SLOTB);
  bf16x8 qr[4];
  #pragma unroll
  for(int d0=0;d0<4;++d0)qr[d0]=*reinterpret_cast<const bf16x8*>(&Qw[(long)r32*DM+d0*16+hi*8]);
  float mhat=0.f,l_reg=0.f;f32x16 o[2];o[0]=f32x16{};o[1]=f32x16{};f32x16 negm=f32x16{};asm volatile("":"+v"(negm));
  const int qrel=wid*QBLK+r32;
  #define CMASK(P0,P1,t) do{int jb_=(t)-(NT-4); if(jb_>=0)cmask(P0,P1,jb_,qrel,hi);}while(0)
  bool resc=false;
  #define START(P0,P1) do{ const float rm=rowmax(P0,P1); resc=false; \
    { const float dl=rm; mhat=fadd_s(mhat,dl); \
      _Pragma("unroll") for(int r=0;r<16;++r){P0[r]=fsub_s(P0[r],dl);P1[r]=fsub_s(P1[r],dl);} \
      _Pragma("unroll") for(int r=0;r<16;++r)negm[r]=-mhat; asm volatile("":"+v"(negm)); } \
    _Pragma("unroll") for(int r=0;r<16;++r)P0[r]=__builtin_amdgcn_exp2f(P0[r]); }while(0)
  #define RESC() do{ if(resc){ asm volatile("s_waitcnt lgkmcnt(0)":::"memory"); \
      _Pragma("unroll") for(int d_=0;d_<2;++d_) _Pragma("unroll") for(int r=0;r<16;++r)o[d_][r]*=wsf[crow(r,hi)]; } }while(0)
  f32x16 pA0,pA1,pB0,pB1;
  int sl_prev=0,sl_cur=0,sl_next=SLOTB;
  #define ROT() do{sl_prev=sl_cur;sl_cur=sl_next;sl_next=(sl_next==(NSLOT-1)*SLOTB)?0:sl_next+SLOTB;}while(0)
  DMA_K(2,2*SLOTB);
  #define SPLIT3(x,H,M,L) do{ const unsigned h_=cvtpk_s((x),0.f)&0xffffu; const float r1_=(x)-__uint_as_float(h_<<16); const unsigned m_=cvtpk_s(r1_,0.f)&0xffffu; const float r2_=r1_-__uint_as_float(m_<<16); H=h_; M=m_; L=cvtpk_s(r2_,0.f)&0xffffu; }while(0)
  if(docp_){ _Pragma("unroll") for(int e_=0;e_<4;++e_){ unsigned fh_,fm_,fl_; const float f_=-fv_[e_]; SPLIT3(f_,fh_,fm_,fl_);
      *(lds_u4*)(shm3+LDS_KA+(tid*4+e_)*16)=(u32x4){fh_|(fm_<<16),fl_|0x3f800000u,0x3f803f80u,0u}; } }
  bf16x8 qa; { unsigned gh_,gm_,gl_; SPLIT3(gq_,gh_,gm_,gl_); const u32x4 w_=hi?(u32x4){0u,0u,0u,0u}:(u32x4){0x3f803f80u,0x3f80u|(gh_<<16),gm_|(gl_<<16),0u}; qa=__builtin_bit_cast(bf16x8,w_); }
  #undef SPLIT3
  const lds_cptr kap=shm3+LDS_KA+r32*16;
  WAIT_BAR(3);
  { const bf16x8 ka0s_=*(lds_cfrag*)(kap), ka1s_=*(lds_cfrag*)(kap+512); qkt(pA0,pA1,Kbase,qr,negm,r32,hi,ka0s_,ka1s_,qa); }asm volatile("s_nop 15\n\ts_nop 7":"+v"(pA0),"+v"(pA1));CMASK(pA0,pA1,0);
  START(pA0,pA1);
  _Pragma("unroll") for(int r=0;r<16;++r)pA1[r]=__builtin_amdgcn_exp2f(pA1[r]);
  WAIT_BAR(0);
  DMA_K(3,0);DMA_V(1,SLOTB);
  ROT();
  kload8(kf,kp0+sl_cur);
  WAIT_BAR(2);
  s16x4 vlo[8],vhi[8]; u32x4 pw0,pw1,pw2,pw3;
  #define PKW(P,B) cvtpk_s(P[B],P[B+1])
  #define PAF(k) __builtin_bit_cast(bf16x8,pw##k)
  #define VFR(i) (bf16x8){vlo[i][0],vlo[i][1],vlo[i][2],vlo[i][3],vhi[i][0],vhi[i][1],vhi[i][2],vhi[i][3]}
  #define PIN(x) asm volatile("":"+v"(x))
  #define MX3(a,b,c) __builtin_fmaxf(__builtin_fmaxf((a),(b)),(c))
  #define GAPA(MF,A0,A1,A2,A3,W0,W1,PW) do{ MF; sacc+=A0; sacc+=A1; sacc+=A2; sacc+=A3; PIN(sacc); W0; W1; PIN(PW); SBAR(); }while(0)
  #define EX(v) __builtin_amdgcn_exp2f(v)
  #define GAPB(MF,X,B) do{ MF; X[B]=EX(X[B]); X[B+1]=EX(X[B+1]); X[B+2]=EX(X[B+2]); X[B+3]=EX(X[B+3]); PIN(X); SBAR(); }while(0)
  #define VRD(i) do{ vlo[i]=vtr(vp_+(((i)>>2)*4096+((i)&3)*1024)); vhi[i]=vtr(vp_+(((i)>>2)*4096+((i)&3)*1024+512)); }while(0)
  #define KRD(G,j) do{ if(G){ kload2(kf,kp0+sl_next,j); SBAR(); } }while(0)
  #define STEP(C0,C1,P0,P1,t,GK,GV,GL) do{ SBAR(); \
    const lds_cptr vp_=vp0+sl_prev; const bf16x8 ka0_=*(lds_cfrag*)(kap+(t)*1024), ka1_=*(lds_cfrag*)(kap+(t)*1024+512); \
    VRD(0); SBAR(); float sacc=(P0[0]+P0[1]); \
    GAPA(C0=__builtin_amdgcn_mfma_f32_32x32x16_bf16(kf[0],qr[0],negm,0,0,0), P0[2],P0[3],P0[4],P0[5],     pw0[0]=PKW(P0,0), pw0[1]=PKW(P0,2), pw0); \
    VRD(4); SBAR(); GAPA(C1=__builtin_amdgcn_mfma_f32_32x32x16_bf16(kf[1],qr[0],negm,0,0,0), P0[6],P0[7],P0[8],P0[9],     pw0[2]=PKW(P0,4), pw0[3]=PKW(P0,6), pw0); \
    VRD(1); SBAR(); GAPA(C0=__builtin_amdgcn_mfma_f32_32x32x16_bf16(kf[2],qr[1],C0,0,0,0),   P0[10],P0[11],P0[12],P0[13], pw1[0]=PKW(P0,8), pw1[1]=PKW(P0,10), pw1); \
    VRD(5); SBAR(); GAPA(C1=__builtin_amdgcn_mfma_f32_32x32x16_bf16(kf[3],qr[1],C1,0,0,0),   P0[14],P0[15],P1[0],P1[1],   pw1[2]=PKW(P0,12),pw1[3]=PKW(P0,14), pw1); \
    VRD(2); SBAR(); GAPA(C0=__builtin_amdgcn_mfma_f32_32x32x16_bf16(kf[4],qr[2],C0,0,0,0),   P1[2],P1[3],P1[4],P1[5],     pw2[0]=PKW(P1,0), pw2[1]=PKW(P1,2), pw2); \
    VRD(6); SBAR(); GAPA(C1=__builtin_amdgcn_mfma_f32_32x32x16_bf16(kf[5],qr[2],C1,0,0,0),   P1[6],P1[7],P1[8],P1[9],     pw2[2]=PKW(P1,4), pw2[3]=PKW(P1,6), pw2); \
    VRD(3); SBAR(); GAPA(C0=__builtin_amdgcn_mfma_f32_32x32x16_bf16(kf[6],qr[3],C0,0,0,0),   P1[10],P1[11],P1[12],P1[13], pw3[0]=PKW(P1,8), pw3[1]=PKW(P1,10), pw3); \
    VRD(7); SBAR(); GAPA(C1=__builtin_amdgcn_mfma_f32_32x32x16_bf16(kf[7],qr[3],C1,0,0,0),   P1[14],P1[15],0.f,0.f,       pw3[2]=PKW(P1,12),pw3[3]=PKW(P1,14), pw3); \
    C0=__builtin_amdgcn_mfma_f32_32x32x16_bf16(ka0_,qa,C0,0,0,0); C1=__builtin_amdgcn_mfma_f32_32x32x16_bf16(ka1_,qa,C1,0,0,0); SBAR(); \
    l_reg+=sacc; \
    if(GK){DMA_K((t)+3,sl_cur);} if(GV){DMA_V((t)+1,sl_next);} \
    CMASK(C0,C1,t); \
    { float a=MX3(C0[0],C0[1],C1[0]),b=MX3(C0[2],C0[3],C1[1]); a=MX3(a,C1[2],C1[3]); \
      _Pragma("unroll") for(int r=4;r<16;r+=4){a=MX3(a,C0[r],C0[r+1]);b=MX3(b,C0[r+2],C0[r+3]);a=MX3(a,C1[r],C1[r+1]);b=MX3(b,C1[r+2],C1[r+3]);} \
      float rm=__builtin_fmaxf(a,b); { auto rr=__builtin_amdgcn_permlane32_swap(__float_as_uint(rm),__float_as_uint(rm),false,false); rm=__builtin_fmaxf(__uint_as_float(rr[0]),__uint_as_float(rr[1])); } \
      resc=false; \
      if(__builtin_expect(__any(rm>(float)THRL),0)){ const float dl=__builtin_fmaxf(rm,0.f); mhat+=dl; \
        _Pragma("unroll") for(int r=0;r<16;++r){C0[r]-=dl;C1[r]-=dl;} \
        _Pragma("unroll") for(int r=0;r<16;++r)negm[r]=-mhat; asm volatile("":"+v"(negm)); \
        const float f=__builtin_amdgcn_exp2f(-dl); l_reg*=f; if(hi==0)wsf[r32]=f; resc=true; } } \
    SBAR(); \
    GAPB(o[0]=__builtin_amdgcn_mfma_f32_32x32x16_bf16(PAF(0),VFR(0),o[0],0,0,0), C0,0); \
    GAPB(o[1]=__builtin_amdgcn_mfma_f32_32x32x16_bf16(PAF(0),VFR(4),o[1],0,0,0), C0,4); \
    KRD(GL,0); GAPB(o[0]=__builtin_amdgcn_mfma_f32_32x32x16_bf16(PAF(1),VFR(1),o[0],0,0,0), C0,8); \
    KRD(GL,1); GAPB(o[1]=__builtin_amdgcn_mfma_f32_32x32x16_bf16(PAF(1),VFR(5),o[1],0,0,0), C0,12); \
    KRD(GL,2); GAPB(o[0]=__builtin_amdgcn_mfma_f32_32x32x16_bf16(PAF(2),VFR(2),o[0],0,0,0), C1,0); \
    KRD(GL,3); GAPB(o[1]=__builtin_amdgcn_mfma_f32_32x32x16_bf16(PAF(2),VFR(6),o[1],0,0,0), C1,4); \
    GAPB(o[0]=__builtin_amdgcn_mfma_f32_32x32x16_bf16(PAF(3),VFR(3),o[0],0,0,0), C1,8); \
    GAPB(o[1]=__builtin_amdgcn_mfma_f32_32x32x16_bf16(PAF(3),VFR(7),o[1],0,0,0), C1,12); \
    }while(0)
  int t=1;
  #undef CMASK
  #define CMASK(P0,P1,t) do{}while(0)
  for(;t+5<NT;t+=2){
    STEP(pB0,pB1,pA0,pA1,t,true,true,true);     WAIT_BAR(2); RESC(); ROT();
    STEP(pA0,pA1,pB0,pB1,t+1,true,true,true);   WAIT_BAR(2); RESC(); ROT();
  }
  #undef CMASK
  #define CMASK(P0,P1,t) do{int jb_=(t)-(NT-4); if(jb_>=0)cmask(P0,P1,jb_,qrel,hi);}while(0)
  #define ENDW(tt) do{ if((tt)+3<NT){WAIT_BAR(2);} else if((tt)+2<NT){WAIT_BAR(1);} else {WAIT_BAR(0);} }while(0)
  for(;t+1<NT;t+=2){
    STEP(pB0,pB1,pA0,pA1,t,(t+3<NT),(t+1<NT),(t+1<NT));       ENDW(t);   RESC(); ROT();
    STEP(pA0,pA1,pB0,pB1,t+1,(t+4<NT),(t+2<NT),(t+2<NT));     ENDW(t+1); RESC(); ROT();
  }
  STEP(pB0,pB1,pA0,pA1,NT-1,false,false,false); RESC();
  { float sacc=pB0[0]+pB0[1]; _Pragma("unroll") for(int r=2;r<16;++r)sacc+=pB0[r]; _Pragma("unroll") for(int r=0;r<16;++r)sacc+=pB1[r]; l_reg+=sacc;
    pw0=(u32x4){PKW(pB0,0),PKW(pB0,2),PKW(pB0,4),PKW(pB0,6)};pw1=(u32x4){PKW(pB0,8),PKW(pB0,10),PKW(pB0,12),PKW(pB0,14)};pw2=(u32x4){PKW(pB1,0),PKW(pB1,2),PKW(pB1,4),PKW(pB1,6)};pw3=(u32x4){PKW(pB1,8),PKW(pB1,10),PKW(pB1,12),PKW(pB1,14)};
    SBAR(); pv(o,vb0+sl_cur,PAF(0),PAF(1),PAF(2),PAF(3)); }
  #undef PKW
  #undef PAF
  #undef VFR
  #undef PIN
  #undef MX3
  #undef GAPA
  #undef GAPB
  #undef EX
  #undef VRD
  #undef KRD
  #undef STEP
  #undef ENDW
  {auto rr=__builtin_amdgcn_permlane32_swap(__float_as_uint(l_reg),__float_as_uint(l_reg),false,false);l_reg=__uint_as_float(rr[0])+__uint_as_float(rr[1]);}
  if(hi==0)wsf[32+r32]=l_reg;asm volatile("s_waitcnt lgkmcnt(0)":::"memory");
  float rli[16];
  #pragma unroll
  for(int r=0;r<16;++r)rli[r]=__builtin_amdgcn_rcpf(wsf[32+crow(r,hi)]);
  bf16*Ow=O+(rowbase+q0+wid*QBLK)*OPITCH+h*D; float*sq=ssq+(rowbase+q0+wid*QBLK)*NHEAD+h;
  { bf16*stg=(bf16*)(shm+LDS_OST)+wid*2048;
    #pragma unroll
    for(int r=0;r<16;++r){const int orow=crow(r,hi);
      #pragma unroll
      for(int d0=0;d0<2;++d0)stg[orow*64+d0*32+r32]=__float2bfloat16(o[d0][r]*rli[r]);}
    asm volatile("s_waitcnt lgkmcnt(0)":::"memory");
    #pragma unroll
    for(int i=0;i<4;++i){const int row=i*8+(lane>>3),ch=lane&7; const u32x4 v=*(const u32x4*)(stg+row*64+ch*8); ATTN_STORE16(Ow+(long)row*OPITCH+ch*8,v);
      float s2=0.f; _Pragma("unroll") for(int e=0;e<4;++e){ const float lo_=__uint_as_float(v[e]<<16), hi_=__uint_as_float(v[e]&0xffff0000u); s2+=lo_*lo_+hi_*hi_; }
      s2+=__shfl_xor(s2,1); s2+=__shfl_xor(s2,2); s2+=__shfl_xor(s2,4); if(ch==0)sq[(long)row*NHEAD]=s2; } }
  asm volatile("s_waitcnt lgkmcnt(0)\n\ts_barrier":::"memory");
  #undef DMA_K
  #undef DMA_V
  #undef CMASK
  #undef START
  #undef RESC
  #undef ROT
}
constexpr int ATTN_LDS_BYTES=LDS_BYTES;
#undef SBAR
#undef WAIT_BAR
}
namespace hg {
#define HLAS __attribute__((address_space(3)))
typedef short bf16x8 __attribute__((ext_vector_type(8)));
typedef short v4i16_t __attribute__((ext_vector_type(4)));
typedef float f32x16 __attribute__((ext_vector_type(16)));
typedef float f32x4 __attribute__((ext_vector_type(4)));
typedef unsigned u32x4 __attribute__((ext_vector_type(4)));
typedef float f32x2_t __attribute__((ext_vector_type(2))); typedef __bf16 bf16x2_t __attribute__((ext_vector_type(2)));
typedef unsigned short bf16_t;
__device__ __forceinline__ unsigned cvtpk(float lo, float hi) { f32x2_t v = {lo, hi}; bf16x2_t b = __builtin_convertvector(v, bf16x2_t); return __builtin_bit_cast(unsigned, b); }
__device__ __forceinline__ unsigned off_b(unsigned row, unsigned ch) { return 272u * row + 16u * ch; }
__device__ __forceinline__ int crow(int reg, int h) { return (reg & 3) + 8 * (reg >> 2) + 4 * h; }
__device__ __forceinline__ bf16x8 pack8(const f32x16& x, int s) {
    u32x4 p; p.x = cvtpk(x[8 * s], x[8 * s + 1]); p.y = cvtpk(x[8 * s + 2], x[8 * s + 3]); p.z = cvtpk(x[8 * s + 4], x[8 * s + 5]); p.w = cvtpk(x[8 * s + 6], x[8 * s + 7]);
    return __builtin_bit_cast(bf16x8, p);
}
__device__ __forceinline__ v4i16_t trd(HLAS const unsigned char* p) { return __builtin_amdgcn_ds_read_tr16_b64_v4i16((HLAS v4i16_t*)p); }
#define HMFMA(a, b, c) __builtin_amdgcn_mfma_f32_32x32x16_bf16((a), (b), (c), 0, 0, 0)
#define HG_BAR() do { asm volatile("s_waitcnt lgkmcnt(0)" ::: "memory"); __builtin_amdgcn_s_barrier(); asm volatile("" ::: "memory"); } while (0)
constexpr int IMG_ONE = 64 * 272, IMG_QT = 0, IMG_QP = IMG_ONE, IMG_KH = 2 * IMG_ONE, IMG_VV = 3 * IMG_ONE, IMG_BYTES = 4 * IMG_ONE, AUX_BYTES = 2560, OB_PITCH = 132;
constexpr int NCH = 32, CH = 64, PITCH = 512, OPITCH = 1024;

__device__ __forceinline__ void hgrn_unit(int unit, const bf16_t* QF, const bf16_t* KK, const bf16_t* VI, const bf16_t* GH, bf16_t* OC, HLAS unsigned char* lds, HLAS unsigned char* aux0) {
    int tid_ = threadIdx.x; asm volatile("" : "+v"(tid_));
    const int tid = tid_, lane = tid & 63, wid = __builtin_amdgcn_readfirstlane(tid >> 6), g = wid >> 2, gw = wid & 3, gt = tid & 255;
    const int bh = unit * 2 + g, b = bh >> 2, h = bh & 3, r32 = lane & 31, hh = lane >> 5;
    HLAS unsigned char* img = lds + g * IMG_BYTES;
    HLAS float* segtot = (HLAS float*)(aux0 + g * AUX_BYTES);
    HLAS float* dec = segtot + 512;
    HLAS float* OB = (HLAS float*)img;
    const size_t rowbase = (size_t)b * 2048; const int cb = h * 128;
    const int blk = (lane >> 4) & 1, tq = (lane & 15) >> 2, tp = lane & 3;
    f32x16 S[4];
#pragma unroll
    for (int i = 0; i < 4; ++i) S[i] = f32x16{};
    unsigned kk2[16], qf2[16]; u32x4 v16[4], g16[4];
#define HG_LOAD_RAW(c) do { const size_t r0_ = rowbase + (size_t)(c) * CH; \
        _Pragma("unroll") for (int i = 0; i < 16; ++i) { const size_t o_ = (r0_ + 16 * gw + i) * PITCH + cb + 2 * lane; kk2[i] = *(const unsigned*)(KK + o_); qf2[i] = *(const unsigned*)(QF + o_); } \
        } while (0)
    HG_LOAD_RAW(0);
    if (g == 1) { HG_BAR(); HG_BAR(); }
    for (int c = 0; c < NCH; ++c) {
        { const size_t r0 = rowbase + (size_t)c * CH;
#pragma unroll
          for (int j = 0; j < 4; ++j) { const int idx = gt + 256 * j; v16[j] = *(const u32x4*)(VI + (r0 + (idx >> 4)) * PITCH + cb + 8 * (idx & 15)); } }
        float bl0[16], bl1[16]; float a0 = 0.f, a1 = 0.f;
#pragma unroll
        for (int i = 0; i < 16; ++i) { const float k0 = __uint_as_float(kk2[i] << 16), k1 = __uint_as_float(kk2[i] & 0xffff0000u);
            a0 += __logf(fmaxf(1.0f - k0, 1e-30f)); a1 += __logf(fmaxf(1.0f - k1, 1e-30f)); bl0[i] = a0; bl1[i] = a1; }
        *(HLAS f32x2_t*)(segtot + gw * 128 + 2 * lane) = (f32x2_t){a0, a1};
        HG_BAR();
        float p0 = 0.f, p1 = 0.f, t0 = 0.f, t1 = 0.f;
#pragma unroll
        for (int w = 0; w < 4; ++w) { const f32x2_t s = *(HLAS const f32x2_t*)(segtot + w * 128 + 2 * lane); if (w < gw) { p0 += s.x; p1 += s.y; } t0 += s.x; t1 += s.y; }
        const float ei0 = __expf(fminf(-t0, 80.f)), ei1 = __expf(fminf(-t1, 80.f));
        if (gw == 0) *(HLAS f32x2_t*)(dec + 2 * lane) = (f32x2_t){__expf(t0), __expf(t1)};
        {
            const int k = 2 * lane, k16 = k & 15, ng = (((k16 >> 2) & 1) << 1) | (k16 >> 3), pos = (k & ~15) + (ng << 2) + (k16 & 3);
            const unsigned chn = (unsigned)(k >> 3), bn = (unsigned)((k & 7) * 2), chp = (unsigned)(pos >> 3), bp = (unsigned)((pos & 7) * 2);
#pragma unroll
            for (int i = 0; i < 16; ++i) { const unsigned row = 16 * gw + i;
                const float k0 = __uint_as_float(kk2[i] << 16), k1 = __uint_as_float(kk2[i] & 0xffff0000u), q0 = __uint_as_float(qf2[i] << 16), q1 = __uint_as_float(qf2[i] & 0xffff0000u);
                const float e0 = __expf(p0 + bl0[i]), e1 = __expf(p1 + bl1[i]);
                const float l0 = fminf(fmaxf(e0 * ei0, 1e-30f), 1e30f), l1 = fminf(fmaxf(e1 * ei1, 1e-30f), 1e30f);
                *(HLAS unsigned*)(img + IMG_QT + off_b(row, chp) + bp) = cvtpk(q0 * e0, q1 * e1);
                *(HLAS unsigned*)(img + IMG_QP + off_b(row, chn) + bn) = cvtpk(q0 * l0, q1 * l1);
                *(HLAS unsigned*)(img + IMG_KH + off_b(row, chn) + bn) = cvtpk(k0 * __builtin_amdgcn_rcpf(l0), k1 * __builtin_amdgcn_rcpf(l1)); }
        }
#pragma unroll
        for (int j = 0; j < 4; ++j) { const int idx = gt + 256 * j; *(HLAS u32x4*)(img + IMG_VV + off_b(idx >> 4, idx & 15)) = v16[j]; }
        HG_BAR();
        { const size_t r0 = rowbase + (size_t)c * CH + (gt >> 2);
#pragma unroll
          for (int j = 0; j < 4; ++j) g16[j] = *(const u32x4*)(GH + r0 * PITCH + cb + 32 * (gt & 3) + 8 * j); }
        if (c + 1 < NCH) HG_LOAD_RAW(c + 1);
        __builtin_amdgcn_sched_barrier(0);
        f32x16 o[2]; o[0] = f32x16{}; o[1] = f32x16{};
#pragma unroll
        for (int kb = 0; kb < 4; ++kb) { const bf16x8 sb0 = pack8(S[kb], 0), sb1 = pack8(S[kb], 1);
#pragma unroll
            for (int tb = 0; tb < 2; ++tb) {
                const bf16x8 a0f = *(HLAS const bf16x8*)(img + IMG_QT + off_b(32 * tb + r32, 4 * kb + hh));
                const bf16x8 a1f = *(HLAS const bf16x8*)(img + IMG_QT + off_b(32 * tb + r32, 4 * kb + 2 + hh));
                o[tb] = HMFMA(a0f, sb0, o[tb]); o[tb] = HMFMA(a1f, sb1, o[tb]); }
            __builtin_amdgcn_sched_barrier(0); }
#pragma unroll
        for (int tb = 0; tb < 2; ++tb)
#pragma unroll
            for (int sb = 0; sb <= tb; ++sb) { f32x16 X = f32x16{};
#pragma unroll
                for (int ks = 0; ks < 8; ++ks) { const bf16x8 af = *(HLAS const bf16x8*)(img + IMG_KH + off_b(32 * sb + r32, 2 * ks + hh)), bf = *(HLAS const bf16x8*)(img + IMG_QP + off_b(32 * tb + r32, 2 * ks + hh));
                    X = HMFMA(af, bf, X); }
                if (sb == tb) {
#pragma unroll
                    for (int r = 0; r < 16; ++r) if (crow(r, hh) > r32) X[r] = 0.f; }
#pragma unroll
                for (int ss = 0; ss < 2; ++ss) { const bf16x8 xa = pack8(X, ss);
                    const unsigned rw = 32 * sb + 16 * ss + 4 * hh + tq;
                    const v4i16_t lo = trd(img + IMG_VV + off_b(rw, 4 * gw + 2 * blk + (tp >> 1)) + 8 * (tp & 1)), hi = trd(img + IMG_VV + off_b(rw + 8, 4 * gw + 2 * blk + (tp >> 1)) + 8 * (tp & 1));
                    const bf16x8 vb = (bf16x8){lo[0], lo[1], lo[2], lo[3], hi[0], hi[1], hi[2], hi[3]};
                    o[tb] = HMFMA(xa, vb, o[tb]); }
                __builtin_amdgcn_sched_barrier(0); }
#pragma unroll
        for (int kb = 0; kb < 4; ++kb)
#pragma unroll
            for (int g4 = 0; g4 < 4; ++g4) { const f32x4 d = *(HLAS const f32x4*)(dec + 32 * kb + 8 * g4 + 4 * hh);
#pragma unroll
                for (int e = 0; e < 4; ++e) S[kb][4 * g4 + e] *= d[e]; }
#pragma unroll
        for (int ss = 0; ss < 4; ++ss) { const unsigned rw = 16 * ss + 8 * hh + tq;
            const v4i16_t vlo = trd(img + IMG_VV + off_b(rw, 4 * gw + 2 * blk + (tp >> 1)) + 8 * (tp & 1)), vhi = trd(img + IMG_VV + off_b(rw + 4, 4 * gw + 2 * blk + (tp >> 1)) + 8 * (tp & 1));
            const bf16x8 vb = (bf16x8){vlo[0], vlo[1], vlo[2], vlo[3], vhi[0], vhi[1], vhi[2], vhi[3]};
#pragma unroll
            for (int kb = 0; kb < 4; ++kb) {
                const v4i16_t klo = trd(img + IMG_KH + off_b(rw, 4 * kb + 2 * blk + (tp >> 1)) + 8 * (tp & 1)), khi = trd(img + IMG_KH + off_b(rw + 4, 4 * kb + 2 * blk + (tp >> 1)) + 8 * (tp & 1));
                const bf16x8 ka = (bf16x8){klo[0], klo[1], klo[2], klo[3], khi[0], khi[1], khi[2], khi[3]};
                S[kb] = HMFMA(ka, vb, S[kb]); }
            __builtin_amdgcn_sched_barrier(0); }
        HG_BAR();
#pragma unroll
        for (int tb = 0; tb < 2; ++tb)
#pragma unroll
            for (int r = 0; r < 16; ++r) OB[(32 * tb + crow(r, hh)) * OB_PITCH + 32 * gw + r32] = o[tb][r];
        HG_BAR();
        { const int t = gt >> 2, qd = gt & 3; f32x4 ov[8]; float ss = 0.f;
#pragma unroll
          for (int j = 0; j < 8; ++j) { ov[j] = *(HLAS const f32x4*)(OB + t * OB_PITCH + 32 * qd + 4 * j); ss += (ov[j][0] * ov[j][0] + ov[j][1] * ov[j][1]) + (ov[j][2] * ov[j][2] + ov[j][3] * ov[j][3]); }
          ss += __shfl_xor(ss, 1); ss += __shfl_xor(ss, 2);
          const float rs = 1.0f / sqrtf(ss * (1.0f / 128.0f) + 1e-6f);
          bf16_t* op = OC + (rowbase + (size_t)c * CH + t) * OPITCH + 512 + cb + 32 * qd;
#pragma unroll
          for (int j = 0; j < 4; ++j) { u32x4 w;
#pragma unroll
              for (int e = 0; e < 4; ++e) { const float ga = __uint_as_float(g16[j][e] << 16), gb = __uint_as_float(g16[j][e] & 0xffff0000u);
                  const int f = 2 * e; const f32x4 va = ov[2 * j + (f >> 2)];
                  w[e] = cvtpk(va[f & 3] * rs * ga, va[(f & 3) + 1] * rs * gb); }
              *(u32x4*)(op + 8 * j) = w; } }
    }
    if (g == 0) { HG_BAR(); HG_BAR(); }
    __syncthreads();
#undef HG_LOAD_RAW
}
#undef HMFMA
#undef HG_BAR
}
#define GAS __attribute__((address_space(1)))
#define LAS __attribute__((address_space(3)))
typedef unsigned short bf16;
typedef unsigned v4u __attribute__((ext_vector_type(4)));
typedef float f32x4 __attribute__((ext_vector_type(4)));
constexpr int T_ = 65536, D_ = 1024, FF_ = 2816, SEQ_ = 2048, NB_ = 32, NMOD_ = 9216, NMIX_ = 3584;
constexpr size_t MiB = 1u << 20;
constexpr size_t WS_CTL = 0, WS_MOD = 2 * MiB, WS_WFG = 4 * MiB, WS_LF = 5 * MiB, WS_SSQ = 7 * MiB, WS_FL2 = 9 * MiB - 0 * MiB;
constexpr size_t WS_W1IN = 12 * MiB, WS_W1OUT = 23 * MiB, WS_WMIX = 29 * MiB, WS_WOUT = 36 * MiB, WS_W2IN = 38 * MiB, WS_W2OUT = 49 * MiB;
constexpr size_t WS_XN = 64 * MiB, WS_H = 192 * MiB, WS_X2 = 640 * MiB, WS_END = 896 * MiB;
constexpr size_t SEGSTRIDE = (size_t)T_ * 512;
static_assert(WS_FL2 + 2 * MiB <= WS_W1IN && WS_W2OUT + 6 * MiB <= WS_XN, "ws map");
constexpr int RING_BYTES = 131072, MISC_OFF = 2 * hg::IMG_BYTES, HG_AUX_OFF = MISC_OFF + 1024, LDS_BYTES = 147456;
static_assert(HG_AUX_OFF + 2 * hg::AUX_BYTES <= LDS_BYTES && attn_body::ATTN_LDS_BYTES <= RING_BYTES, "LDS map");
constexpr float LOG2E = 1.4426950408889634f;

struct Frame {
    LAS unsigned char* lds; volatile LAS unsigned* MISC;
    int tid, lane, wave, G;
    const float* in[19]; float* out; unsigned char* ws;
};
__device__ __forceinline__ float wave_sum(float v) {
#pragma unroll
    for (int o = 1; o < 64; o <<= 1) v += __shfl_xor(v, o);
    return v;
}
__device__ __forceinline__ unsigned f2bf(float f) { unsigned u = __builtin_bit_cast(unsigned, f); return (u + 0x7fffu + ((u >> 16) & 1u)) >> 16; }
__device__ __forceinline__ unsigned pk2(float lo, float hi) { return f2bf(lo) | (f2bf(hi) << 16); }
#define LDS_WAIT() asm volatile("s_waitcnt lgkmcnt(0)" ::: "memory")
#define XB_TMO      128
#define XB_XCNT(j)  (256  + 64 * (j))
#define XB_XSUB(j)  (1280 + 64 * (j))
#define XB_XGEN(j)  (2304 + 64 * (j))
#define XB_TOP      3328
#define XB_TOPGEN   3392
#define XCD_BAR_WORDS 3456
#define XB_SPIN_CAP (1u << 18)

__device__ __forceinline__ unsigned xb_ld(unsigned* p)              { return __hip_atomic_load(p, __ATOMIC_RELAXED, __HIP_MEMORY_SCOPE_AGENT); }
__device__ __forceinline__ unsigned xb_add(unsigned* p, unsigned v) { return __hip_atomic_fetch_add(p, v, __ATOMIC_RELAXED, __HIP_MEMORY_SCOPE_AGENT); }
__device__ __forceinline__ unsigned xb_xcc_id() { return (unsigned)__builtin_amdgcn_s_getreg((3 << 11) | 20) & 0xFu; }
#define XB_SPIN(cond, bar) do { unsigned _sp = 0; while (cond) { __builtin_amdgcn_s_sleep(1); \
    if ((++_sp & 255u) == 0u) { if (xb_ld(&(bar)[XB_TMO])) break; if (_sp > XB_SPIN_CAP) { atomicAdd(&(bar)[XB_TMO], 1u); break; } } } } while (0)

struct XcdBarrier {
    unsigned* bar; unsigned x;
    volatile LAS unsigned* st;
};

__device__ __forceinline__ XcdBarrier xcd_barrier_post(unsigned* bar, volatile LAS unsigned* st) {
    XcdBarrier b; b.bar = bar; b.x = xb_xcc_id(); b.st = st;
    if (threadIdx.x == 0) (void)xb_add(&bar[XB_XCNT(b.x)], 1u);
    return b;
}
__device__ __forceinline__ void xcd_barrier_complete(unsigned* bar, unsigned x, unsigned& nloc, unsigned& nx) {
    const unsigned G = gridDim.x * gridDim.y * gridDim.z;
    unsigned sum, cnt, mine, sp = 0u;
    for (;;) {
        sum = 0u; cnt = 0u; mine = 0u;
#pragma unroll
        for (unsigned j = 0; j < 16; ++j) { const unsigned c = xb_ld(&bar[XB_XCNT(j)]); sum += c; cnt += (c > 0u) ? 1u : 0u; mine = (j == x) ? c : mine; }
        if (sum == G) break;
        __builtin_amdgcn_s_sleep(1);
        if ((++sp & 255u) == 0u) { if (xb_ld(&bar[XB_TMO])) break; if (sp > XB_SPIN_CAP) { atomicAdd(&bar[XB_TMO], 1u); break; } }
    }
    nloc = mine > 0u ? mine : 1u; nx = cnt > 0u ? cnt : 1u;
}

__device__ __forceinline__ void xcd_barrier(const XcdBarrier& b) {
    asm volatile("s_waitcnt vmcnt(0)" ::: "memory");
    __syncthreads();
    if (threadIdx.x == 0) {
        unsigned* bar = b.bar;
        __builtin_amdgcn_s_waitcnt(0);
        unsigned nloc = b.st[0], nx = b.st[1];
        if (nloc == 0u) { xcd_barrier_complete(bar, b.x, nloc, nx); b.st[0] = nloc; b.st[1] = nx; }
        const unsigned old = xb_add(&bar[XB_XSUB(b.x)], 1u);
        const unsigned gen = old / nloc;
        if (old + 1u == (gen + 1u) * nloc) {
            __builtin_amdgcn_fence(__ATOMIC_RELEASE, "agent");
            asm volatile("s_waitcnt vmcnt(0)" ::: "memory");
            const unsigned og = xb_add(&bar[XB_TOP], 1u);
            const unsigned tg = og / nx;
            if (og + 1u == (tg + 1u) * nx) xb_add(&bar[XB_TOPGEN], 1u);
            else XB_SPIN(xb_ld(&bar[XB_TOPGEN]) == tg, bar);
            __builtin_amdgcn_fence(__ATOMIC_ACQUIRE, "agent");
            xb_add(&bar[XB_XGEN(b.x)], 1u);
            asm volatile("s_waitcnt vmcnt(0)" ::: "memory");
        } else {
            XB_SPIN(xb_ld(&bar[XB_XGEN(b.x)]) == gen, bar);
            __builtin_amdgcn_fence(__ATOMIC_ACQUIRE, "agent");
            asm volatile("s_waitcnt vmcnt(0)" ::: "memory");
        }
    }
    __syncthreads();
}

__device__ __forceinline__ void tr_item(const float* W, int ldw, int K, int k0, int n_src0, bf16* WT, int dst_row0, const float* ka, const float* kb, LAS float* scr, int lane) {
#pragma unroll 8
    for (int i = 0; i < 32; ++i) { const int kk = 2 * i + (lane >> 5); float w = W[(size_t)(k0 + kk) * ldw + n_src0 + (lane & 31)];
        if (ka) { const int k = k0 + kk; w *= (k < 512) ? ka[k] : kb[k - 512]; }
        scr[kk * 33 + (lane & 31)] = w; }
    LDS_WAIT(); asm volatile("" ::: "memory");
    const int c = lane & 7;
#pragma unroll
    for (int j = 0; j < 4; ++j) { const int n = (lane >> 3) + 8 * j; const LAS float* s = scr + (8 * c) * 33 + n;
        v4u o; o.x = pk2(s[0 * 33], s[1 * 33]); o.y = pk2(s[2 * 33], s[3 * 33]); o.z = pk2(s[4 * 33], s[5 * 33]); o.w = pk2(s[6 * 33], s[7 * 33]);
        *(v4u*)(WT + (size_t)(dst_row0 + n) * K + k0 + 8 * c) = o; }
    LDS_WAIT(); asm volatile("" ::: "memory");
}
__device__ __forceinline__ void p0_ffn_in_item(const float* W, bf16* WT, int r, LAS float* scr, int lane) {
    const int kb = r / 176, nb = r % 176, ns = 32 * nb; int dst;
    if (ns < FF_) dst = 256 * (ns / 128) + (ns % 128); else { const int c = ns - FF_; dst = 256 * (c / 128) + 128 + (c % 128); }
    tr_item(W, 2 * FF_, D_, 64 * kb, ns, WT, dst, nullptr, nullptr, scr, lane);
}
__device__ __forceinline__ void p0_mix_item(const float* W, bf16* WT, int r, LAS float* scr, int lane) {
    const int kb = r / 112, db = r % 112, seg = db >> 4, t = 32 * (db & 15), half = t >> 8, tt = t & 255;
    int feat = t; if (seg < 2) { const int bj = tt >> 7, wc = (tt & 127) >> 5; feat = 256 * half + 64 * wc + 32 * bj; }
    const int srcb = (seg < 3) ? 512 * seg : 1544 + 512 * (seg - 3);
    tr_item(W, 3592, D_, 64 * kb, srcb + feat, WT, 32 * db, nullptr, nullptr, scr, lane);
}
__device__ __forceinline__ void p0_prologue(Frame& F0) {
    Frame F = F0; { int t_ = threadIdx.x; asm volatile("" : "+v"(t_)); F.tid = t_; F.lane = t_ & 63; }
    float* mod = (float*)(F.ws + WS_MOD);
    for (int item = blockIdx.x; item < NMOD_ / 64; item += F.G) {
        LAS float* cs = (LAS float*)F.lds;
        for (int i = F.tid; i < NB_ * D_; i += 512) { const float c = F.in[1][i]; cs[i] = c / (1.0f + __expf(-c)); }
        __syncthreads();
        const int col = item * 64 + F.lane, k0 = F.wave * 128;
        float acc[32];
#pragma unroll
        for (int b = 0; b < 32; ++b) acc[b] = 0.f;
        const float* wp = F.in[2] + (size_t)k0 * NMOD_ + col;
        for (int k = 0; k < 128; k += 4) {
            const float w0 = wp[(size_t)k * NMOD_], w1 = wp[(size_t)(k + 1) * NMOD_], w2 = wp[(size_t)(k + 2) * NMOD_], w3 = wp[(size_t)(k + 3) * NMOD_];
#pragma unroll
            for (int b = 0; b < 32; ++b) { const f32x4 c4 = *(const LAS f32x4*)(cs + b * D_ + k0 + k); acc[b] += (c4[0] * w0 + c4[1] * w1) + (c4[2] * w2 + c4[3] * w3); }
        }
        __syncthreads();
        LAS float* red = cs;
#pragma unroll
        for (int b = 0; b < 32; ++b) red[(F.wave * 32 + b) * 64 + F.lane] = acc[b];
        __syncthreads();
        for (int o = F.tid; o < 2048; o += 512) { const int b = o >> 6, l = o & 63; float s = 0.f;
#pragma unroll
            for (int w = 0; w < 8; ++w) s += red[(w * 32 + b) * 64 + l];
            mod[(size_t)b * NMOD_ + item * 64 + l] = s + F.in[3][item * 64 + l]; }
        __syncthreads();
    }
    { float* wfg = (float*)(F.ws + WS_WFG); const int gi = blockIdx.x * 512 + F.tid;
      for (int i = gi; i < 8 * D_; i += F.G * 512) wfg[i] = F.in[8][(size_t)(i & 1023) * 3592 + 1536 + (i >> 10)]; }
    LAS float* scr = (LAS float*)(F.lds + F.wave * 16384);
    const int gw = blockIdx.x * 8 + F.wave, NGW = F.G * 8;
    constexpr int I_IN = 16 * 176, I_OUT = 44 * 32, I_MIX = 16 * 112, I_WO = 16 * 32, NITEMS = 2 * I_IN + 2 * I_OUT + I_MIX + I_WO;
    for (int it = gw; it < NITEMS; it += NGW) {
        int r = it;
        if (r < I_IN) { p0_ffn_in_item(F.in[5], (bf16*)(F.ws + WS_W1IN), r, scr, F.lane); continue; } r -= I_IN;
        if (r < I_IN) { p0_ffn_in_item(F.in[17], (bf16*)(F.ws + WS_W2IN), r, scr, F.lane); continue; } r -= I_IN;
        if (r < I_OUT) { tr_item(F.in[6], D_, FF_, 64 * (r / 32), 32 * (r % 32), (bf16*)(F.ws + WS_W1OUT), 32 * (r % 32), nullptr, nullptr, scr, F.lane); continue; } r -= I_OUT;
        if (r < I_OUT) { tr_item(F.in[18], D_, FF_, 64 * (r / 32), 32 * (r % 32), (bf16*)(F.ws + WS_W2OUT), 32 * (r % 32), nullptr, nullptr, scr, F.lane); continue; } r -= I_OUT;
        if (r < I_MIX) { p0_mix_item(F.in[8], (bf16*)(F.ws + WS_WMIX), r, scr, F.lane); continue; } r -= I_MIX;
        tr_item(F.in[15], D_, D_, 64 * (r / 32), 32 * (r % 32), (bf16*)(F.ws + WS_WOUT), 32 * (r % 32), F.in[12], F.in[14], scr, F.lane);
    }
}
template <bool SRCB> __device__ __forceinline__ f32x4 ld_row4(const float* src, size_t e) {
    if (!SRCB) return *(const f32x4*)(src + e);
    const unsigned long long w = *(const unsigned long long*)((const bf16*)src + e); const unsigned lo = (unsigned)w, hi = (unsigned)(w >> 32);
    return (f32x4){__uint_as_float(lo << 16), __uint_as_float(lo & 0xffff0000u), __uint_as_float(hi << 16), __uint_as_float(hi & 0xffff0000u)};
}
template <int MODE, bool SRCB> __device__ __forceinline__ void norm_phase(Frame& F0, const float* src, const float* g, int sh_chunk, int sc_chunk) {
    Frame F = F0; { int t_ = threadIdx.x; asm volatile("" : "+v"(t_)); F.tid = t_; F.lane = t_ & 63; }
    const float* mod = (const float*)(F.ws + WS_MOD); bf16* XN = (bf16*)(F.ws + WS_XN);
    LAS float* wl = (LAS float*)F.lds;
    if (MODE == 1) { const float* wfg = (const float*)(F.ws + WS_WFG); for (int i = F.tid; i < 8 * D_; i += 512) wl[i] = wfg[i]; __syncthreads(); }
    const int gw = blockIdx.x * 8 + F.wave, NGW = F.G * 8;
    for (int r0 = gw * 32; r0 < T_; r0 += NGW * 32) {
        const int b = r0 / SEQ_; const float* mp = mod + (size_t)b * NMOD_;
        f32x4 A[4], Bv[4];
#pragma unroll
        for (int j = 0; j < 4; ++j) { const int col = 4 * F.lane + 256 * j; const f32x4 gg = *(const f32x4*)(g + col), sc = *(const f32x4*)(mp + sc_chunk * D_ + col);
            A[j] = gg * (sc + 1.0f); Bv[j] = *(const f32x4*)(mp + sh_chunk * D_ + col); }
        f32x4 nv[4];
#pragma unroll
        for (int j = 0; j < 4; ++j) nv[j] = ld_row4<SRCB>(src, (size_t)r0 * D_ + 4 * F.lane + 256 * j);
        for (int r = r0; r < r0 + 32; ++r) {
            f32x4 v[4]; float ss = 0.f;
#pragma unroll
            for (int j = 0; j < 4; ++j) { v[j] = nv[j]; ss += (v[j][0] * v[j][0] + v[j][1] * v[j][1]) + (v[j][2] * v[j][2] + v[j][3] * v[j][3]); }
            if (r + 1 < r0 + 32) {
#pragma unroll
                for (int j = 0; j < 4; ++j) nv[j] = ld_row4<SRCB>(src, (size_t)(r + 1) * D_ + 4 * F.lane + 256 * j); }
            const float rstd = 1.0f / sqrtf(wave_sum(ss) * (1.0f / D_) + 1e-6f);
#pragma unroll
            for (int j = 0; j < 4; ++j) { v[j] = v[j] * rstd * A[j] + Bv[j];
                *(unsigned long long*)(XN + (size_t)r * D_ + 4 * F.lane + 256 * j) = (unsigned long long)pk2(v[j][0], v[j][1]) | ((unsigned long long)pk2(v[j][2], v[j][3]) << 32); }
            if (MODE == 1) {
                float d[8];
#pragma unroll
                for (int h = 0; h < 8; ++h) { float s = 0.f;
#pragma unroll
                    for (int j = 0; j < 4; ++j) { const f32x4 w = *(const LAS f32x4*)(wl + h * D_ + 4 * F.lane + 256 * j); s += (v[j][0] * w[0] + v[j][1] * w[1]) + (v[j][2] * w[2] + v[j][3] * w[3]); }
                    d[h] = wave_sum(s); }
                float z = d[0];
#pragma unroll
                for (int h = 1; h < 8; ++h) z = (F.lane == h) ? d[h] : z;
                if (F.lane < 8) { z += F.in[9][F.lane]; ((float*)(F.ws + WS_LF))[(size_t)r * 8 + F.lane] = fminf(z, 0.f) - __logf(1.0f + __expf(-fabsf(z))); }
            }
        }
    }
    if (MODE == 1) __syncthreads();
}
__device__ __forceinline__ void fscan_phase(Frame& F0) {
    Frame F = F0; { int t_ = threadIdx.x; asm volatile("" : "+v"(t_)); F.tid = t_; F.lane = t_ & 63; }
    const float* LF = (const float*)(F.ws + WS_LF); float* FL2 = (float*)(F.ws + WS_FL2);
    LAS float* wsum = (LAS float*)F.lds;
    for (int bh = blockIdx.x; bh < 256; bh += F.G) { const int b = bh >> 3, h = bh & 7;
        float p[4]; float a = 0.f;
#pragma unroll
        for (int i = 0; i < 4; ++i) { a += LF[((size_t)b * SEQ_ + 4 * F.tid + i) * 8 + h]; p[i] = a; }
        float incl = a;
#pragma unroll
        for (int o = 1; o < 64; o <<= 1) { const float t = __shfl_up(incl, o); if (F.lane >= o) incl += t; }
        if (F.lane == 63) wsum[F.wave] = incl;
        __syncthreads();
        float woff = 0.f;
#pragma unroll
        for (int w = 0; w < 8; ++w) woff += (w < F.wave) ? wsum[w] : 0.f;
        const float ex = woff + incl - a;
        f32x4 o4; o4[0] = (ex + p[0]) * LOG2E; o4[1] = (ex + p[1]) * LOG2E; o4[2] = (ex + p[2]) * LOG2E; o4[3] = (ex + p[3]) * LOG2E;
        *(f32x4*)(FL2 + (size_t)bh * SEQ_ + 4 * F.tid) = o4;
        __syncthreads();
    }
}

#ifndef PHASE_MASK
#define PHASE_MASK 0x7ff
#endif
#ifndef P6SEL
#define P6SEL 0
#endif
#ifndef REPEAT_MASK
#define REPEAT_MASK 0
#endif
#define PH(k) if constexpr (((PHASE_MASK) >> (k)) & 1) for (int rep_ = 0; rep_ < 1 + (((REPEAT_MASK) >> (k)) & 1); ++rep_)
struct Args { const float* in[19]; float* out; unsigned char* ws; int pad0, pad1; };
__global__ void __launch_bounds__(512, 2) fwd_mega(Args args) {
    extern __shared__ __attribute__((aligned(16))) unsigned char lds[];
    cg::grid_group grid = cg::this_grid();
    Frame F;
    F.lds = (LAS unsigned char*)lds; F.MISC = (volatile LAS unsigned*)(F.lds + MISC_OFF);
    F.tid = threadIdx.x; F.lane = F.tid & 63; F.wave = __builtin_amdgcn_readfirstlane(F.tid >> 6); F.G = gridDim.x;
#pragma unroll
    for (int i = 0; i < 19; ++i) F.in[i] = args.in[i];
    F.out = args.out; F.ws = args.ws;
    unsigned char* ws = args.ws;
    float* mod = (float*)(ws + WS_MOD);
    bf16* XN = (bf16*)(ws + WS_XN); bf16* HB = (bf16*)(ws + WS_H); bf16* PJ = (bf16*)(ws + WS_H); float* X2 = (float*)(ws + WS_X2);
    const int bid = (int)blockIdx.x;
    if (threadIdx.x < 16) F.MISC[threadIdx.x] = 0u;
    __syncthreads();
    const XcdBarrier xbar = xcd_barrier_post((unsigned*)(ws + WS_CTL + 16384), F.MISC + 8);
#define GSYNC() xcd_barrier(xbar)

    PH(0) p0_prologue(F);
    grid.sync();
#ifdef SYNC_PROBE
    for (int i_ = 0; i_ < 20; ++i_) grid.sync();
#endif
    PH(1) norm_phase<0, false>(F, F.in[0], F.in[4], 0, 1);
    GSYNC();
    PH(2) { pg8::Gemm g{XN, (const bf16*)(ws + WS_W1IN), T_, 2 * FF_, D_}; pg8::StaticOrder S; S.init(T_, 2 * FF_, F.G, bid);
      pg8::EpiSwiGLU E{HB, FF_};
      pg8::gemm_phase<pg8::EpiSwiGLU, pg8::StaticOrder, true, true>(F.lds, g, S, E); }
    GSYNC();
    PH(3) { pg8::Gemm g{HB, (const bf16*)(ws + WS_W1OUT), T_, D_, FF_}; pg8::StaticOrder S; S.init(T_, D_, F.G, bid);
      pg8::EpiResid<false> E{F.in[0], F.out, mod + 2 * D_, 0.5f, nullptr};
      pg8::gemm_phase<pg8::EpiResid<false>, pg8::StaticOrder, true, true>(F.lds, g, S, E); }
    GSYNC();
    PH(4) norm_phase<1, false>(F, F.out, F.in[7], 3, 4);
    GSYNC();
    PH(5) fscan_phase(F);
    PH(5) { pg8::Gemm g{XN, (const bf16*)(ws + WS_WMIX), T_, NMIX_, D_}; pg8::StaticOrder S; S.init(T_, NMIX_, F.G, bid);
      pg8::EpiMix E{PJ, SEGSTRIDE, F.in[10], F.in[11], F.in[13], attn_body::C2};
      pg8::gemm_phase<pg8::EpiMix, pg8::StaticOrder, true, true>(F.lds, g, S, E); }
    GSYNC();
    PH(6) {
        const int xl = bid & 7;
        unsigned* q = (unsigned*)(ws + WS_CTL) + 1024 * rep_ + 64 * xl;
        const attn_body::bf16* Qp = (const attn_body::bf16*)PJ; const attn_body::bf16* Kp = Qp + SEGSTRIDE; const attn_body::bf16* Vp = Qp + 2 * SEGSTRIDE;
        for (;;) {
            if (threadIdx.x == 0) F.MISC[0] = atomicAdd(q, 1u);
            __syncthreads();
            const int idx = (int)F.MISC[0];
            __syncthreads();
            if (idx >= 8 + 256) break;
            if (idx < 8) { if (!(rep_ == 1 && P6SEL >= 2)) hg::hgrn_unit(xl + 8 * idx, PJ + 3 * SEGSTRIDE, PJ + 4 * SEGSTRIDE, PJ + 5 * SEGSTRIDE, PJ + 6 * SEGSTRIDE, XN, F.lds, F.lds + HG_AUX_OFF); }
            else if (!(rep_ == 1 && P6SEL == 1)) { const int a = idx - 8, bh = xl + 8 * (a & 31), qb = 7 - (a >> 5);
                const float* Fg = (const float*)(ws + WS_FL2) + (size_t)bh * SEQ_;
                attn_body::attn_unit<90, true>(bh >> 3, bh & 7, qb, Qp, Kp, Vp, (attn_body::bf16*)XN, Fg, (float*)(ws + WS_SSQ), (char*)lds); }
        }
    }
    GSYNC();
    PH(7) { pg8::Gemm g{XN, (const bf16*)(ws + WS_WOUT), T_, D_, D_}; pg8::StaticOrder S; S.init(T_, D_, F.G, bid);
      pg8::EpiResid<true> E{F.out, X2, mod + 5 * D_, 1.0f, (const float*)(ws + WS_SSQ)};
      pg8::gemm_phase<pg8::EpiResid<true>, pg8::StaticOrder, true, true>(F.lds, g, S, E); }
    GSYNC();
    PH(8) norm_phase<0, false>(F, X2, F.in[16], 6, 7);
    GSYNC();
    PH(9) { pg8::Gemm g{XN, (const bf16*)(ws + WS_W2IN), T_, 2 * FF_, D_}; pg8::StaticOrder S; S.init(T_, 2 * FF_, F.G, bid);
      pg8::EpiSwiGLU E{HB, FF_};
      pg8::gemm_phase<pg8::EpiSwiGLU, pg8::StaticOrder, true, true>(F.lds, g, S, E); }
    GSYNC();
    PH(10) { pg8::Gemm g{HB, (const bf16*)(ws + WS_W2OUT), T_, D_, FF_}; pg8::StaticOrder S; S.init(T_, D_, F.G, bid);
      pg8::EpiResid<false> E{X2, F.out, mod + 8 * D_, 0.5f, nullptr};
      pg8::gemm_phase<pg8::EpiResid<false>, pg8::StaticOrder, true, true>(F.lds, g, S, E); }
}

extern "C" void kernel_launch(void* const* d_in, const int* in_sizes, int n_in, void* d_out, int out_size, void* d_ws, size_t ws_size, hipStream_t stream) {
    static int grid = 0;
    if (grid == 0) {
        int dev = 0, cus = 0, per_cu = 0;
        if (n_in != 19 || out_size != T_ * D_ || ws_size < WS_END) { fprintf(stderr, "kernel_launch: unexpected shapes (n_in %d out %d ws %zu)\n", n_in, out_size, ws_size); grid = -1; return; }
        (void)hipGetDevice(&dev);
        (void)hipDeviceGetAttribute(&cus, hipDeviceAttributeMultiprocessorCount, dev);
        (void)hipFuncSetAttribute((const void*)fwd_mega, hipFuncAttributeMaxDynamicSharedMemorySize, LDS_BYTES);
        (void)hipOccupancyMaxActiveBlocksPerMultiprocessor(&per_cu, (const void*)fwd_mega, 512, LDS_BYTES);
        (void)hipGetLastError();
        grid = cus > 0 ? cus : 256;
        fprintf(stderr, "kernel_launch: cus %d per_cu %d grid %d ws %zu\n", cus, per_cu, grid, ws_size);
    }
    if (grid < 0) return;
    (void)hipMemsetAsync((char*)d_ws + WS_CTL, 0, 65536, stream);
    Args a{};
    for (int i = 0; i < 19; ++i) a.in[i] = (const float*)d_in[i];
    a.out = (float*)d_out; a.ws = (unsigned char*)d_ws;
    void* args[] = {&a};
    hipError_t e = hipLaunchCooperativeKernel((const void*)fwd_mega, dim3(grid), dim3(512), args, LDS_BYTES, stream);
    if (e != hipSuccess) fprintf(stderr, "cooperative launch failed: %s (grid %d)\n", hipGetErrorString(e), grid);
}
```

```cpp
#include <hip/hip_runtime.h>
#include <hip/hip_cooperative_groups.h>
#include <cstdio>
#include <cstdint>
namespace cg = cooperative_groups;
namespace pg8 {
#define PG8_LAS __attribute__((address_space(3)))
typedef unsigned short bf16_t;
typedef short bf16x8 __attribute__((ext_vector_type(8)));
typedef float f32x4 __attribute__((ext_vector_type(4)));
typedef unsigned u32x4 __attribute__((ext_vector_type(4)));
constexpr int BM = 256, BK = 64, HALF = 128, HTB = HALF * BK * 2  , STAGE_BYTES = 8 * HTB, NXCD = 8, WGM = 4;

__host__ __device__ __forceinline__ int lds_byte(int r, int c) { const int st = (r >> 4) * 2 + (c >> 5), rr = r & 15, cc = c & 31, ob = rr * 64 + cc * 2; return st * 1024 + (ob ^ (((ob >> 9) & 1) << 5)); }
__host__ __device__ __forceinline__ void stage_rc(int b, int& R, int& C) { const int st = b / 1024, sb = b % 1024, swz = sb ^ (((sb >> 9) & 1) << 5); R = (st >> 1) * 16 + swz / 64; C = (st & 1) * 32 + (swz % 64) / 2; }
__host__ __device__ __forceinline__ int perm32(int rho) { const int n = rho >> 4, i = rho & 15; return 8 * (i >> 2) + 4 * n + (i & 3); }

struct Unit { int pm, pn; };
struct Gemm { const bf16_t* A; const bf16_t* Bt; int M, N, K; int atile; };

struct StaticOrder {
    int nM, nN, nwg, G, c;
    __host__ __device__ void init(int M, int N, int G_, int c_) { nM = M / BM; nN = N / BM; nwg = nM * nN; G = G_; c = c_; }
    __host__ __device__ bool next(int i, Unit& u) const {
        const long L = (long)i * G + c; if (L >= nwg) return false;
        int wgid = (int)L; { const int q = nwg / NXCD, r = nwg % NXCD, xcd = wgid % NXCD, off = wgid / NXCD; wgid = (xcd < r ? xcd * (q + 1) : r * (q + 1) + (xcd - r) * q) + off; }
        const int nig = WGM * nN, gid = wgid / nig, fm = gid * WGM, gsz = (nM - fm) < WGM ? (nM - fm) : WGM;
        u.pm = fm + ((wgid % nig) % gsz); u.pn = (wgid % nig) / gsz; return true;
    }
    __device__ __forceinline__ void a_ready(const Unit&) const {}
    __device__ __forceinline__ void done(const Unit&) const {}
};

__device__ __forceinline__ unsigned cvt_pk_bf16(float lo, float hi) { unsigned r; asm volatile("v_cvt_pk_bf16_f32 %0, %1, %2" : "=v"(r) : "v"(lo), "v"(hi)); return r; }
typedef float f32x2 __attribute__((ext_vector_type(2)));
__device__ __forceinline__ float silu_f(float x) { return x * __builtin_amdgcn_rcpf(1.0f + __expf(-x)); }
struct EpiSwiGLU {
    static constexpr bool PERM = true, AFTER_DRAIN = false, MID = false; static constexpr int MID_T = -1; static constexpr bool SPLIT = true, FUSEDN = false;
    bf16_t* O; int ldc;
    __device__ __forceinline__ void mid(f32x4 (&)[2][2][4][2], const Unit&, int, int) const {}
    __device__ __forceinline__ void operator()(const f32x4 (&acc)[2][2][4][2], const Unit& u, int wr, int wc, int fr, int fq) const {
        const int ln = fr + 16 * fq, srcl = 4 * ((ln >> 2) + 16 * (ln & 3));
        bf16_t* blk0 = O + ((size_t)(u.pm * 16 + wr * 4) * (ldc >> 5) + u.pn * 4 + wc) * 512 + ln * 8;
#pragma unroll
        for (int ai = 0; ai < 2; ++ai)
#pragma unroll
            for (int m = 0; m < 4; ++m) { bf16_t* p = blk0 + (size_t)(ai * 8 + m) * (ldc >> 5) * 512;
                const f32x4 g0 = acc[ai][0][m][0], g1 = acc[ai][0][m][1], u0 = acc[ai][1][m][0], u1 = acc[ai][1][m][1];
                u32x4 w; w.x = cvt_pk_bf16(silu_f(g0[0]) * u0[0], silu_f(g0[1]) * u0[1]); w.y = cvt_pk_bf16(silu_f(g0[2]) * u0[2], silu_f(g0[3]) * u0[3]);
                w.z = cvt_pk_bf16(silu_f(g1[0]) * u1[0], silu_f(g1[1]) * u1[1]); w.w = cvt_pk_bf16(silu_f(g1[2]) * u1[2], silu_f(g1[3]) * u1[3]);
                u32x4 wp; wp.x = (unsigned)__builtin_amdgcn_ds_bpermute(srcl, (int)w.x); wp.y = (unsigned)__builtin_amdgcn_ds_bpermute(srcl, (int)w.y); wp.z = (unsigned)__builtin_amdgcn_ds_bpermute(srcl, (int)w.z); wp.w = (unsigned)__builtin_amdgcn_ds_bpermute(srcl, (int)w.w);
                __builtin_nontemporal_store(wp, (u32x4*)p); }
    }
};
template <bool MIDF> struct EpiResid {
    static constexpr bool PERM = true, AFTER_DRAIN = false, MID = MIDF; static constexpr int MID_T = 8; static constexpr bool SPLIT = false, FUSEDN = false;
    const float* base; float* out; const float* gate; float coef; const float* ssq;
    __device__ __forceinline__ void mid(f32x4 (&acc)[2][2][4][2], const Unit& u, int wr, int fr) const {
#pragma unroll
        for (int ai = 0; ai < 2; ++ai)
#pragma unroll
            for (int m = 0; m < 4; ++m) { const size_t row = (size_t)(u.pm * BM + ai * HALF + wr * 64 + m * 16 + fr);
                const f32x4 a = *(const f32x4*)(ssq + row * 8), b = *(const f32x4*)(ssq + row * 8 + 4);
                const float s = ((a[0] + a[1]) + (a[2] + a[3])) + ((b[0] + b[1]) + (b[2] + b[3]));
                const float rs = 1.0f / sqrtf(s * (1.0f / 512.0f) + 1e-6f);
#pragma unroll
                for (int bj = 0; bj < 2; ++bj)
#pragma unroll
                    for (int n = 0; n < 2; ++n) acc[ai][bj][m][n] = acc[ai][bj][m][n] * rs; }
    }
    __device__ __forceinline__ void operator()(const f32x4 (&acc)[2][2][4][2], const Unit& u, int wr, int wc, int fr, int fq) const {
        const int b = u.pm >> 3; const float* gp = gate + (size_t)b * 9216; const int col0 = u.pn * BM + wc * 32 + 8 * fq;
        f32x4 gv[2][2];
#pragma unroll
        for (int bj = 0; bj < 2; ++bj)
#pragma unroll
            for (int n = 0; n < 2; ++n) gv[bj][n] = *(const f32x4*)(gp + col0 + bj * HALF + n * 4) * coef;
#pragma unroll
        for (int ai = 0; ai < 2; ++ai)
#pragma unroll
            for (int m = 0; m < 4; ++m) { const size_t off = (size_t)(u.pm * BM + ai * HALF + wr * 64 + m * 16 + fr) * 1024 + col0;
#pragma unroll
                for (int bj = 0; bj < 2; ++bj)
#pragma unroll
                    for (int n = 0; n < 2; ++n) { const f32x4 bs = *(const f32x4*)(base + off + bj * HALF + n * 4); *(f32x4*)(out + off + bj * HALF + n * 4) = bs + gv[bj][n] * acc[ai][bj][m][n]; }
                if (m & 1) asm volatile("" ::: "memory"); }
    }
};
template <bool MIDF> struct EpiResidNorm {
    static constexpr bool PERM = true, AFTER_DRAIN = false, MID = MIDF; static constexpr int MID_T = 8; static constexpr bool SPLIT = false, FUSEDN = true;
    const float* base; float* out; unsigned char* ws; const float* gn; float coef;
    static constexpr size_t O_MOD = (size_t)2 << 20, O_LF = (size_t)5 << 20, O_SSQ = (size_t)7 << 20, O_XN2 = (size_t)896 << 20, O_CNT = 65536;
    static constexpr int C_GATE = 5, C_SH = 6, C_SC = 7;
    __device__ __forceinline__ void mid(f32x4 (&acc)[2][2][4][2], const Unit& u, int wr, int fr_) const {
        int fr = fr_; asm volatile("" : "+v"(fr));
#pragma unroll
        for (int ai = 0; ai < 2; ++ai)
#pragma unroll
            for (int m = 0; m < 4; ++m) { const size_t row = (size_t)(u.pm * BM + ai * HALF + wr * 64 + m * 16 + fr);
                const float* ssq = (const float*)(ws + O_SSQ); const f32x4 a = *(const f32x4*)(ssq + row * 8), b = *(const f32x4*)(ssq + row * 8 + 4);
                const float s = ((a[0] + a[1]) + (a[2] + a[3])) + ((b[0] + b[1]) + (b[2] + b[3]));
                const float rs = 1.0f / sqrtf(s * (1.0f / 512.0f) + 1e-6f);
#pragma unroll
                for (int bj = 0; bj < 2; ++bj)
#pragma unroll
                    for (int n = 0; n < 2; ++n) acc[ai][bj][m][n] = acc[ai][bj][m][n] * rs; }
    }
    __device__ __forceinline__ void fusedn(f32x4 (&acc)[2][2][4][2], const Unit& u, int wr, int wc, int fr_, int fq_, PG8_LAS unsigned char* lds, int wid, int lane_) const {
        int fr = fr_, fq = fq_, lane = lane_; asm volatile("" : "+v"(fr), "+v"(fq), "+v"(lane));
        PG8_LAS float* P = (PG8_LAS float*)(lds + 140288);
        PG8_LAS float* S = P + 1024;
        const int b = u.pm >> 3; const float* modb = (const float*)(ws + O_MOD) + (size_t)b * 9216; const float* gp = modb + C_GATE * 1024; const int col0 = u.pn * BM + wc * 32 + 8 * fq;
        unsigned* slots = (unsigned*)(ws + O_LF); unsigned* cnt = (unsigned*)(ws + O_CNT); bf16_t* xn = (bf16_t*)(ws + O_XN2);
        f32x4 gv[2][2];
#pragma unroll
        for (int bj = 0; bj < 2; ++bj)
#pragma unroll
            for (int n = 0; n < 2; ++n) gv[bj][n] = *(const f32x4*)(gp + col0 + bj * HALF + n * 4) * coef;
#pragma unroll
        for (int ai = 0; ai < 2; ++ai)
#pragma unroll
            for (int m = 0; m < 4; ++m) { const size_t off = (size_t)(u.pm * BM + ai * HALF + wr * 64 + m * 16 + fr) * 1024 + col0; float s = 0.f;
#pragma unroll
                for (int bj = 0; bj < 2; ++bj)
#pragma unroll
                    for (int n = 0; n < 2; ++n) { const f32x4 bs = *(const f32x4*)(base + off + bj * HALF + n * 4); const f32x4 o = bs + gv[bj][n] * acc[ai][bj][m][n];
                        acc[ai][bj][m][n] = o; s += (o[0] * o[0] + o[1] * o[1]) + (o[2] * o[2] + o[3] * o[3]); }
                s += __shfl_xor(s, 16); s += __shfl_xor(s, 32);
                if (fq == 0) P[(ai * HALF + wr * 64 + m * 16 + fr) * 4 + wc] = s;
                asm volatile("" ::: "memory"); }
        asm volatile("s_waitcnt lgkmcnt(0)" ::: "memory"); __builtin_amdgcn_s_barrier(); asm volatile("" ::: "memory");
        const int row = wid * 32 + (lane & 31);
        if (lane < 32) { const f32x4 p = *(const PG8_LAS f32x4*)(P + row * 4);
            __hip_atomic_store(slots + ((size_t)(u.pm * BM + row) * 4 + u.pn), __float_as_uint((p[0] + p[1]) + (p[2] + p[3])), __ATOMIC_RELAXED, __HIP_MEMORY_SCOPE_AGENT); }
        asm volatile("s_waitcnt vmcnt(0)" ::: "memory");
        if (lane == 0) __hip_atomic_fetch_add(cnt + 64 * u.pm, 1u, __ATOMIC_RELAXED, __HIP_MEMORY_SCOPE_AGENT);
#pragma unroll
        for (int ai = 0; ai < 2; ++ai)
#pragma unroll
            for (int m = 0; m < 4; ++m) { const size_t off = (size_t)(u.pm * BM + ai * HALF + wr * 64 + m * 16 + fr) * 1024 + col0;
#pragma unroll
                for (int bj = 0; bj < 2; ++bj)
#pragma unroll
                    for (int n = 0; n < 2; ++n) *(f32x4*)(out + off + bj * HALF + n * 4) = acc[ai][bj][m][n]; }
        if (wid == 0) { unsigned sp = 0;
            while ((unsigned)__builtin_amdgcn_readfirstlane(__hip_atomic_load(cnt + 64 * u.pm, __ATOMIC_RELAXED, __HIP_MEMORY_SCOPE_AGENT)) < 32u) { __builtin_amdgcn_s_sleep(2); if (++sp > (1u << 24)) break; }
            __builtin_amdgcn_fence(__ATOMIC_ACQUIRE, "agent"); }
        asm volatile("s_waitcnt vmcnt(0) lgkmcnt(0)" ::: "memory"); __builtin_amdgcn_s_barrier(); asm volatile("" ::: "memory");
        if (lane < 32) { const unsigned* sl = slots + (size_t)(u.pm * BM + row) * 4; float t = 0.f;
#pragma unroll
            for (int k = 0; k < 4; ++k) t += __uint_as_float(__hip_atomic_load(sl + k, __ATOMIC_RELAXED, __HIP_MEMORY_SCOPE_AGENT));
            S[row] = 1.0f / sqrtf(t * (1.0f / 1024.0f) + 1e-6f); }
        asm volatile("s_waitcnt lgkmcnt(0)" ::: "memory"); __builtin_amdgcn_s_barrier(); asm volatile("" ::: "memory");
#pragma unroll
        for (int bj = 0; bj < 2; ++bj) { f32x4 An[2], Bn[2];
#pragma unroll
            for (int n = 0; n < 2; ++n) { const int c = col0 + bj * HALF + n * 4; const f32x4 g4 = *(const f32x4*)(gn + c), s4 = *(const f32x4*)(modb + C_SC * 1024 + c);
                An[n] = g4 * (s4 + 1.0f); Bn[n] = *(const f32x4*)(modb + C_SH * 1024 + c); }
#pragma unroll
            for (int ai = 0; ai < 2; ++ai)
#pragma unroll
                for (int m = 0; m < 4; ++m) { const int rl = ai * HALF + wr * 64 + m * 16 + fr; const float r = S[rl]; const size_t off = (size_t)(u.pm * BM + rl) * 1024 + col0;
                    const f32x4 v0 = acc[ai][bj][m][0] * r * An[0] + Bn[0], v1 = acc[ai][bj][m][1] * r * An[1] + Bn[1];
                    u32x4 w; w.x = cvt_pk_bf16(v0[0], v0[1]); w.y = cvt_pk_bf16(v0[2], v0[3]); w.z = cvt_pk_bf16(v1[0], v1[1]); w.w = cvt_pk_bf16(v1[2], v1[3]);
                    *(u32x4*)(xn + off + bj * HALF) = w; }
            asm volatile("" ::: "memory"); }
    }
};
struct EpiMix {
    static constexpr bool PERM = true, AFTER_DRAIN = false, MID = false; static constexpr int MID_T = -1; static constexpr bool SPLIT = false, FUSEDN = false;
    bf16_t* P; size_t segstride; const float* qg; const float* kg; const float* lbl; float c2;
    __device__ __forceinline__ void mid(f32x4 (&)[2][2][4][2], const Unit&, int, int) const {}
    __device__ __forceinline__ void operator()(const f32x4 (&acc)[2][2][4][2], const Unit& u, int wr, int wc, int fr, int fq) const {
        const int seg = u.pn >> 1, half = u.pn & 1;
        bf16_t* base = P + (size_t)seg * segstride + (size_t)(u.pm * BM + wr * 64 + fr) * 512 + 256 * half;
        if (seg < 2) {
            const float* g = seg == 0 ? qg : kg; const float sc = seg == 0 ? c2 : 1.0f;
            f32x4 gn[2][2];
#pragma unroll
            for (int bj = 0; bj < 2; ++bj)
#pragma unroll
                for (int n = 0; n < 2; ++n) gn[bj][n] = *(const f32x4*)(g + 32 * bj + 8 * fq + 4 * n) * sc;
#pragma unroll
            for (int ai = 0; ai < 2; ++ai)
#pragma unroll
                for (int m = 0; m < 4; ++m) { float ss = 0.f;
#pragma unroll
                    for (int bj = 0; bj < 2; ++bj)
#pragma unroll
                        for (int n = 0; n < 2; ++n) { const f32x4 x = acc[ai][bj][m][n]; ss += (x[0] * x[0] + x[1] * x[1]) + (x[2] * x[2] + x[3] * x[3]); }
                    ss += __shfl_xor(ss, 16); ss += __shfl_xor(ss, 32);
                    const float rs = 1.0f / sqrtf(ss * (1.0f / 64.0f) + 1e-6f);
#pragma unroll
                    for (int bj = 0; bj < 2; ++bj) { const f32x4 v0 = acc[ai][bj][m][0] * gn[bj][0] * rs, v1 = acc[ai][bj][m][1] * gn[bj][1] * rs;
                        u32x4 w; w.x = cvt_pk_bf16(v0[0], v0[1]); w.y = cvt_pk_bf16(v0[2], v0[3]); w.z = cvt_pk_bf16(v1[0], v1[1]); w.w = cvt_pk_bf16(v1[2], v1[3]);
                        *(u32x4*)(base + (size_t)(ai * HALF + m * 16) * 512 + 64 * wc + 32 * bj + 8 * fq) = w; } }
        } else {
            const int cw = wc * 32 + 8 * fq;
            f32x4 om[2][2];
#pragma unroll
            for (int bj = 0; bj < 2; ++bj)
#pragma unroll
                for (int n = 0; n < 2; ++n) { om[bj][n] = (f32x4){1.f, 1.f, 1.f, 1.f};
                    if (seg == 4) { const int c = 256 * half + 128 * bj + cw + 4 * n; const f32x4 l0 = *(const f32x4*)(lbl + c), l1 = *(const f32x4*)(lbl + 512 + c);
#pragma unroll
                        for (int e = 0; e < 4; ++e) om[bj][n][e] = __builtin_amdgcn_rcpf(1.0f + __expf(l0[e] - l1[e])); } }
#pragma unroll
            for (int ai = 0; ai < 2; ++ai)
#pragma unroll
                for (int m = 0; m < 4; ++m)
#pragma unroll
                    for (int bj = 0; bj < 2; ++bj) { f32x4 v0 = acc[ai][bj][m][0], v1 = acc[ai][bj][m][1];
                        if (seg == 3 || seg == 6) {
#pragma unroll
                            for (int e = 0; e < 4; ++e) { v0[e] = silu_f(v0[e]); v1[e] = silu_f(v1[e]); }
                        } else if (seg == 4) {
#pragma unroll
                            for (int e = 0; e < 4; ++e) { v0[e] = om[bj][0][e] * __builtin_amdgcn_rcpf(1.0f + __expf(v0[e])); v1[e] = om[bj][1][e] * __builtin_amdgcn_rcpf(1.0f + __expf(v1[e])); }
                        }
                        u32x4 w; w.x = cvt_pk_bf16(v0[0], v0[1]); w.y = cvt_pk_bf16(v0[2], v0[3]); w.z = cvt_pk_bf16(v1[0], v1[1]); w.w = cvt_pk_bf16(v1[2], v1[3]);
                        *(u32x4*)(base + (size_t)(ai * HALF + m * 16) * 512 + 128 * bj + cw) = w; }
        }
    }
};
template <class Epi, class Sched, bool ALIGN_EPI = false, bool SP2 = false>
__device__ __forceinline__ void gemm_phase(PG8_LAS unsigned char* lds, const Gemm g, const Sched& S, const Epi& E) {
    int tid_ = threadIdx.x; asm volatile("" : "+v"(tid_));
    const int tid = tid_, wid = __builtin_amdgcn_readfirstlane(tid >> 6), lane = tid & 63, wr = wid >> 2, wc = wid & 3, fr = lane & 15, fq = lane >> 4;
    const int K = g.K, nt = K / BK;
    unsigned voffA[2], voffB[2];
#pragma unroll
    for (int i = 0; i < 2; ++i) { int R, C; stage_rc(tid * 16 + i * 8192, R, C); const int Rb = Epi::PERM ? ((R & ~31) + perm32(R & 31)) : R;
        voffA[i] = g.atile ? (unsigned)(((R >> 4) * (K >> 5) + (C >> 5)) * 1024 + ((R & 15) * 4 + ((C & 31) >> 3)) * 16) : (unsigned)(R * K + C) * 2u;
        voffB[i] = (unsigned)(Rb * K + C) * 2u; }
    const size_t kstep = (size_t)(BK * 2);
    const size_t hstep = (size_t)HALF * K * 2;
    const size_t tstep = 2 * hstep;
    const size_t kstepA = g.atile ? (size_t)2048 : kstep, hstepA = g.atile ? (size_t)8 * (K >> 5) * 1024 : hstep, tstepA = 2 * hstepA;
    const unsigned ldsw = (unsigned)wid * 1024u;
    const int aoff = lds_byte(wr * 64 + fr, fq * 8), boff = lds_byte(wc * 32 + fr, fq * 8);
#define PG8_SA(b, h) (((b) * 2 + (h)) * HTB)
#define PG8_SB(b, h) ((4 + (b) * 2 + (h)) * HTB)
#define PG8_STAGE(bufoff, gbase, voff) do { _Pragma("unroll") for (int _i = 0; _i < 2; ++_i) \
        __builtin_amdgcn_global_load_lds((const unsigned*)((const char*)(gbase) + (voff)[_i]), (PG8_LAS unsigned*)(lds + (bufoff) + ldsw + _i * 8192), 16, 0, 0); } while (0)
#define PG8_LDA(dst, b, h) do { _Pragma("unroll") for (int m = 0; m < 4; ++m) _Pragma("unroll") for (int k = 0; k < 2; ++k) dst[m][k] = *(const PG8_LAS bf16x8*)(lds + PG8_SA(b, h) + aoff + m * 2048 + k * 1024); } while (0)
#define PG8_LDB(dst, b, h) do { _Pragma("unroll") for (int n = 0; n < 2; ++n) _Pragma("unroll") for (int k = 0; k < 2; ++k) dst[n][k] = *(const PG8_LAS bf16x8*)(lds + PG8_SB(b, h) + boff + n * 2048 + k * 1024); } while (0)
#define PG8_MMA(ai, bj, At, Bt) do { __builtin_amdgcn_s_setprio(1); _Pragma("unroll") for (int m = 0; m < 4; ++m) _Pragma("unroll") for (int n = 0; n < 2; ++n) _Pragma("unroll") for (int k = 0; k < 2; ++k) \
        acc[ai][bj][m][n] = __builtin_amdgcn_mfma_f32_16x16x32_bf16(Bt[n][k], At[m][k], acc[ai][bj][m][n], 0, 0, 0); __builtin_amdgcn_s_setprio(0); } while (0)
#define PG8_WAIT_V(n) asm volatile("s_waitcnt vmcnt(" #n ")" ::: "memory")
#define PG8_WAIT_V_UNLESS(n, flag) asm volatile("s_cmp_lg_u32 %0, 0\n\ts_cbranch_scc1 .Lpg8skip%=\n\ts_waitcnt vmcnt(" #n ")\n.Lpg8skip%=:" :: "s"(flag) : "memory", "scc")
#define PG8_WAIT_L(n) asm volatile("s_waitcnt lgkmcnt(" #n ")" ::: "memory")
#define PG8_BAR __builtin_amdgcn_s_barrier()
#define PG8_SCHED __builtin_amdgcn_sched_barrier(0)
    Unit cur, nxt; int ui = 0;
    if (!S.next(0, cur)) return;
    f32x4 acc[2][2][4][2];
#pragma unroll
    for (int a = 0; a < 2; ++a)
#pragma unroll
        for (int b = 0; b < 2; ++b)
#pragma unroll
            for (int m = 0; m < 4; ++m)
#pragma unroll
                for (int n = 0; n < 2; ++n) acc[a][b][m][n] = (f32x4){0.f, 0.f, 0.f, 0.f};
    bf16x8 At[4][2], B0[2][2], B1[2][2];
    const char* cA = (const char*)g.A + (size_t)cur.pm * tstepA; const char* cB = (const char*)g.Bt + (size_t)cur.pn * tstep;
    S.a_ready(cur);
    if constexpr (SP2) {
        PG8_STAGE(PG8_SB(0, 0), cB, voffB); PG8_STAGE(PG8_SB(0, 1), cB + hstep, voffB); PG8_STAGE(PG8_SA(0, 0), cA, voffA); PG8_STAGE(PG8_SA(0, 1), cA + hstepA, voffA);
        if (wr == 1) PG8_BAR;
        PG8_WAIT_V(2); PG8_BAR;
        PG8_STAGE(PG8_SB(1, 0), cB + kstep, voffB); PG8_STAGE(PG8_SA(1, 0), cA + kstepA, voffA); PG8_STAGE(PG8_SB(1, 1), cB + hstep + kstep, voffB);
        PG8_WAIT_V(6); PG8_BAR;
    } else {
        PG8_STAGE(PG8_SB(0, 0), cB, voffB); PG8_STAGE(PG8_SA(0, 0), cA, voffA); PG8_STAGE(PG8_SB(0, 1), cB + hstep, voffB); PG8_STAGE(PG8_SA(0, 1), cA + hstepA, voffA);
        if (wr == 1) PG8_BAR;
        PG8_WAIT_V(4); PG8_BAR;
        PG8_STAGE(PG8_SB(1, 0), cB + kstep, voffB); PG8_STAGE(PG8_SA(1, 0), cA + kstepA, voffA); PG8_STAGE(PG8_SB(1, 1), cB + hstep + kstep, voffB);
        PG8_WAIT_V(6); PG8_BAR;
    }
    for (;;) {
        const bool has_next = S.next(ui + 1, nxt);
        const char* nA = has_next ? (const char*)g.A + (size_t)nxt.pm * tstepA : cA; const char* nB = has_next ? (const char*)g.Bt + (size_t)nxt.pn * tstep : cB;
        for (int t = 0; t < nt; t += 2) {
            if constexpr (Epi::MID) { if (t == Epi::MID_T) E.mid(acc, cur, wr, fr); }
            const bool last = (t == nt - 2);
            const char* a1 = cA + (size_t)(t + 1) * kstepA;
            const char* a2 = last ? nA : cA + (size_t)(t + 2) * kstepA; const char* b2 = last ? nB : cB + (size_t)(t + 2) * kstep;
            const char* a3 = a2 + kstepA; const char* b3 = b2 + kstep;
            if (last && has_next) S.a_ready(nxt);
            const int skipw = __builtin_amdgcn_readfirstlane((Epi::SPLIT && t == 0 && ui > 0) ? 1 : 0);
            if constexpr (SP2) {
            PG8_LDB(B0, 0, 0); PG8_LDB(B1, 0, 1); PG8_SCHED; PG8_LDA(At, 0, 0); PG8_STAGE(PG8_SA(1, 1), a1 + hstepA, voffA);
            PG8_WAIT_V_UNLESS(8, skipw); PG8_WAIT_L(0); PG8_BAR; PG8_MMA(0, 0, At, B0); PG8_MMA(0, 1, At, B1); PG8_BAR; PG8_SCHED;
            PG8_LDA(At, 0, 1); PG8_STAGE(PG8_SB(0, 0), b2, voffB); PG8_STAGE(PG8_SB(0, 1), b2 + hstep, voffB); PG8_STAGE(PG8_SA(0, 0), a2, voffA);
            PG8_WAIT_V_UNLESS(8, skipw); PG8_WAIT_L(0); PG8_BAR; PG8_MMA(1, 0, At, B0); PG8_MMA(1, 1, At, B1); PG8_BAR; PG8_SCHED;
            PG8_LDB(B0, 1, 0); PG8_LDB(B1, 1, 1); PG8_SCHED; PG8_LDA(At, 1, 0); PG8_STAGE(PG8_SA(0, 1), a2 + hstepA, voffA);
            PG8_WAIT_V(8); PG8_WAIT_L(0); PG8_BAR; PG8_MMA(0, 0, At, B0); PG8_MMA(0, 1, At, B1); PG8_BAR; PG8_SCHED;
            PG8_LDA(At, 1, 1); PG8_STAGE(PG8_SB(1, 0), b3, voffB); PG8_STAGE(PG8_SB(1, 1), b3 + hstep, voffB); PG8_STAGE(PG8_SA(1, 0), a3, voffA);
            PG8_WAIT_V(8); PG8_WAIT_L(0); PG8_BAR; PG8_MMA(1, 0, At, B0); PG8_MMA(1, 1, At, B1); PG8_BAR; PG8_SCHED;
            } else {
            PG8_LDB(B0, 0, 0); PG8_SCHED; PG8_LDA(At, 0, 0); PG8_STAGE(PG8_SA(1, 1), a1 + hstepA, voffA);
            PG8_WAIT_L(8); PG8_BAR; PG8_WAIT_L(0); PG8_MMA(0, 0, At, B0); PG8_BAR; PG8_SCHED;
            PG8_LDB(B1, 0, 1); PG8_STAGE(PG8_SB(0, 0), b2, voffB);
            PG8_BAR; PG8_WAIT_L(0); PG8_MMA(0, 1, At, B1); PG8_BAR;
            PG8_LDA(At, 0, 1); PG8_STAGE(PG8_SA(0, 0), a2, voffA);
            PG8_BAR; PG8_WAIT_L(0); PG8_MMA(1, 0, At, B0); PG8_BAR; PG8_SCHED;
            PG8_STAGE(PG8_SB(0, 1), b2 + hstep, voffB);
            PG8_WAIT_V(6); PG8_BAR; PG8_MMA(1, 1, At, B1); PG8_BAR;
            PG8_LDB(B0, 1, 0); PG8_SCHED; PG8_LDA(At, 1, 0); PG8_STAGE(PG8_SA(0, 1), a2 + hstepA, voffA);
            PG8_WAIT_L(8); PG8_BAR; PG8_WAIT_L(0); PG8_MMA(0, 0, At, B0); PG8_BAR; PG8_SCHED;
            PG8_LDB(B1, 1, 1); PG8_STAGE(PG8_SB(1, 0), b3, voffB);
            PG8_BAR; PG8_WAIT_L(0); PG8_MMA(0, 1, At, B1); PG8_BAR;
            PG8_LDA(At, 1, 1); PG8_STAGE(PG8_SA(1, 0), a3, voffA);
            PG8_BAR; PG8_WAIT_L(0); PG8_MMA(1, 0, At, B0); PG8_BAR; PG8_SCHED;
            PG8_STAGE(PG8_SB(1, 1), b3 + hstep, voffB);
            PG8_WAIT_V(6); PG8_BAR; PG8_MMA(1, 1, At, B1); PG8_BAR;
            }
        }
        if constexpr (ALIGN_EPI) { if (wr == 0) PG8_BAR; }
        if constexpr (Epi::SPLIT) PG8_WAIT_V(0);
        if constexpr (!Epi::AFTER_DRAIN) { if constexpr (Epi::FUSEDN) { static_assert(ALIGN_EPI, "the fused-norm epilogue has workgroup barriers: both halves must reach it together"); E.fusedn(acc, cur, wr, wc, fr, fq, lds, wid, lane); } else E(acc, cur, wr, wc, fr, fq); S.done(cur); }
        if (!has_next) break;
#pragma unroll
        for (int a = 0; a < 2; ++a)
#pragma unroll
            for (int b = 0; b < 2; ++b)
#pragma unroll
                for (int m = 0; m < 4; ++m)
#pragma unroll
                    for (int n = 0; n < 2; ++n) acc[a][b][m][n] = (f32x4){0.f, 0.f, 0.f, 0.f};
        cur = nxt; cA = nA; cB = nB; ++ui;
        if constexpr (ALIGN_EPI) { if (wr == 1) PG8_BAR; }
    }
    PG8_WAIT_V(0);
    if constexpr (!ALIGN_EPI) { if (wr == 0) PG8_BAR; }
    PG8_BAR;
    if constexpr (Epi::AFTER_DRAIN) { E.fused(acc, cur, wr, wc, fr, fq, lds, wid, lane); S.done(cur); }
#undef PG8_SA
#undef PG8_SB
#undef PG8_STAGE
#undef PG8_LDA
#undef PG8_LDB
#undef PG8_MMA
#undef PG8_WAIT_V
#undef PG8_WAIT_V_UNLESS
#undef PG8_WAIT_L
#undef PG8_BAR
#undef PG8_SCHED
}
}
#include <hip/hip_bf16.h>
#include <cmath>
namespace attn_body {
using bf16=__hip_bfloat16;
using bf16x8=__attribute__((ext_vector_type(8)))short;
using s16x4=__attribute__((ext_vector_type(4)))short;
using f32x16=__attribute__((ext_vector_type(16)))float;
using u32x4=__attribute__((ext_vector_type(4)))unsigned;
constexpr int BATCH=32,NHEAD=8,SEQ=2048,D=64,DM=512,OPITCH=1024;
constexpr int NW=8,QBLK=32,QB=QBLK*NW,KVBLK=64,NQB=SEQ/QB;
constexpr int ATTN_PITCH=DM, ATTN_UNIT_ROWS=QB;
__device__ __forceinline__ int crow(int r,int hi){return (r&3)+8*(r>>2)+4*hi;}
#define SBAR() __builtin_amdgcn_sched_barrier(0)
__device__ __forceinline__ void cmask(f32x16&p0,f32x16&p1,int jb,int qrel,int hi){
  const float NEG=-INFINITY; int kb=64*jb+4*hi;
  #pragma unroll
  for(int r=0;r<16;++r){int kv=kb+(r&3)+8*(r>>2); if(kv>qrel)p0[r]=NEG; if(kv+32>qrel)p1[r]=NEG;}
}

constexpr int NSLOT=3, SLOTB=8192;
constexpr int LDS_K=0, LDS_V=NSLOT*SLOTB, LDS_WS=2*NSLOT*SLOTB, LDS_OST=LDS_WS+NW*64*4, LDS_KA=LDS_OST+NW*4096,LDS_BYTES=LDS_KA+SEQ*16;
constexpr float C2=0.125f*1.4426950408889634f;
__device__ __forceinline__ void glds16(const void*gsrc,unsigned lds_dst){unsigned keep;
  asm volatile("s_mov_b32 %0, m0\n\ts_mov_b32 m0, %2\n\ts_nop 0\n\tglobal_load_lds_dwordx4 %1, off\n\ts_mov_b32 m0, %0":"=&s"(keep):"v"(gsrc),"s"(lds_dst):"memory");}
__device__ __forceinline__ float max3f(float a,float b,float c){float r;asm("v_max3_f32 %0, %1, %2, %3":"=v"(r):"v"(a),"v"(b),"v"(c));return r;}
__device__ __forceinline__ float max2f(float a,float b){float r;asm("v_max_f32_e32 %0, %1, %2":"=v"(r):"v"(a),"v"(b));return r;}
__device__ __forceinline__ float fadd_s(float a,float b){float r;asm("v_add_f32_e32 %0, %1, %2":"=v"(r):"v"(a),"v"(b));return r;}
__device__ __forceinline__ float fsub_s(float a,float b){float r;asm("v_sub_f32_e32 %0, %1, %2":"=v"(r):"v"(a),"v"(b));return r;}
typedef float f32x2_t __attribute__((ext_vector_type(2))); typedef __bf16 bf16x2_t __attribute__((ext_vector_type(2)));
__device__ __forceinline__ unsigned cvtpk_s(float lo,float hi){f32x2_t v={lo,hi};bf16x2_t b=__builtin_convertvector(v,bf16x2_t);return __builtin_bit_cast(unsigned,b);}
#define WAIT_BAR(N) asm volatile("s_waitcnt vmcnt(" #N ") lgkmcnt(0)\n\ts_barrier":::"memory")

__device__ __forceinline__ void qkt(f32x16&p0,f32x16&p1,const char*Kslot,const bf16x8*qr,const f32x16&negm,int r32,int hi,const bf16x8&ka0,const bf16x8&ka1,const bf16x8&qa){
  const char*kb=Kslot+hi*1024+r32*16;
  #pragma unroll
  for(int d0=0;d0<4;++d0){
    const bf16x8 b0=*reinterpret_cast<const bf16x8*>(kb+d0*2048);
    const bf16x8 b1=*reinterpret_cast<const bf16x8*>(kb+d0*2048+512);
    if(d0==0){p0=__builtin_amdgcn_mfma_f32_32x32x16_bf16(b0,qr[0],negm,0,0,0);p1=__builtin_amdgcn_mfma_f32_32x32x16_bf16(b1,qr[0],negm,0,0,0);}
    else{p0=__builtin_amdgcn_mfma_f32_32x32x16_bf16(b0,qr[d0],p0,0,0,0);p1=__builtin_amdgcn_mfma_f32_32x32x16_bf16(b1,qr[d0],p1,0,0,0);}}
  p0=__builtin_amdgcn_mfma_f32_32x32x16_bf16(ka0,qa,p0,0,0,0);p1=__builtin_amdgcn_mfma_f32_32x32x16_bf16(ka1,qa,p1,0,0,0);
}
typedef __attribute__((address_space(3))) const char* lds_cptr;
typedef short v4i16_t __attribute__((ext_vector_type(4)));
__device__ __forceinline__ void kload8(bf16x8*kf,lds_cptr kp){
  kf[0]=*(const __attribute__((address_space(3))) bf16x8*)(kp);      kf[1]=*(const __attribute__((address_space(3))) bf16x8*)(kp+512);
  kf[2]=*(const __attribute__((address_space(3))) bf16x8*)(kp+2048); kf[3]=*(const __attribute__((address_space(3))) bf16x8*)(kp+2560);
  kf[4]=*(const __attribute__((address_space(3))) bf16x8*)(kp+4096); kf[5]=*(const __attribute__((address_space(3))) bf16x8*)(kp+4608);
  kf[6]=*(const __attribute__((address_space(3))) bf16x8*)(kp+6144); kf[7]=*(const __attribute__((address_space(3))) bf16x8*)(kp+6656);
}
__device__ __forceinline__ void kload2(bf16x8*kf,lds_cptr kp,int j){ kf[2*j]=*(const __attribute__((address_space(3))) bf16x8*)(kp+j*2048); kf[2*j+1]=*(const __attribute__((address_space(3))) bf16x8*)(kp+j*2048+512); }
__device__ __forceinline__ s16x4 vtr(lds_cptr p){ return __builtin_bit_cast(s16x4,__builtin_amdgcn_ds_read_tr16_b64_v4i16((__attribute__((address_space(3))) v4i16_t*)p)); }
__device__ __forceinline__ float rowmax(const f32x16&p0,const f32x16&p1){
  float a=max3f(p0[0],p0[1],p1[0]),b=max3f(p0[2],p0[3],p1[1]);a=max3f(a,p1[2],p1[3]);
  #pragma unroll
  for(int r=4;r<16;r+=4){a=max3f(a,p0[r],p0[r+1]);b=max3f(b,p0[r+2],p0[r+3]);a=max3f(a,p1[r],p1[r+1]);b=max3f(b,p1[r+2],p1[r+3]);}
  const float m=max2f(a,b);
  auto rr=__builtin_amdgcn_permlane32_swap(__float_as_uint(m),__float_as_uint(m),false,false);
  return max2f(__uint_as_float(rr[0]),__uint_as_float(rr[1]));
}
__device__ __forceinline__ void pv(f32x16*o,int vb,bf16x8 pa0,bf16x8 pa1,bf16x8 pa2,bf16x8 pa3){
  #pragma unroll
  for(int d0=0;d0<2;++d0){s16x4 lo[4],hi[4];
    #pragma unroll
    for(int ks=0;ks<4;++ks){
      asm volatile("ds_read_b64_tr_b16 %0,%1 offset:%c2":"=&v"(lo[ks]):"v"(vb),"i"(d0*4096+ks*1024):"memory");
      asm volatile("ds_read_b64_tr_b16 %0,%1 offset:%c2":"=&v"(hi[ks]):"v"(vb),"i"(d0*4096+ks*1024+512):"memory");}
    asm volatile("s_waitcnt lgkmcnt(0)":::"memory");SBAR();
    #define PK(k) (bf16x8){lo[k][0],lo[k][1],lo[k][2],lo[k][3],hi[k][0],hi[k][1],hi[k][2],hi[k][3]}
    o[d0]=__builtin_amdgcn_mfma_f32_32x32x16_bf16(pa0,PK(0),o[d0],0,0,0);
    o[d0]=__builtin_amdgcn_mfma_f32_32x32x16_bf16(pa1,PK(1),o[d0],0,0,0);
    o[d0]=__builtin_amdgcn_mfma_f32_32x32x16_bf16(pa2,PK(2),o[d0],0,0,0);
    o[d0]=__builtin_amdgcn_mfma_f32_32x32x16_bf16(pa3,PK(3),o[d0],0,0,0);
    #undef PK
  }
}

#ifndef ATTN_STORE16
#define ATTN_STORE16(p,v) (*(u32x4*)(p)=(v))
#endif
template<int THRL,bool COPYF> __device__ __forceinline__ void attn_unit(int b,int h,int qb,const bf16*Q,const bf16*__restrict__ K,const bf16*__restrict__ V,bf16*O,const float*__restrict__ Fg,float*__restrict__ ssq,char*shm){
  int tid_=threadIdx.x; asm volatile("":"+v"(tid_)); const int tid=tid_,lane=tid&63,r32=lane&31,hi=lane>>5; const int wid=__builtin_amdgcn_readfirstlane(tid>>6);
  const long rowbase=(long)b*SEQ; const int q0=qb*QB;
  const bf16*Qw=Q+(rowbase+q0+wid*QBLK)*DM+h*D;
  const bf16*Kh=K+rowbase*DM+h*D,*Vh=V+rowbase*DM+h*D;
  const lds_cptr shm3=(lds_cptr)shm;
  const unsigned lds0=(unsigned)(uintptr_t)shm;
  float*wsf=(float*)(shm+LDS_WS)+wid*64;
  const bf16*ksrc=Kh+(long)lane*DM+wid*8;
  const bf16*vsrc=Vh+(long)(16*(wid&3)+(lane>>2))*DM+(wid>>2)*32+(lane&3)*8;
  const unsigned kdst=lds0+LDS_K+wid*1024, vdst=lds0+LDS_V+wid*1024;
  #define DMA_K(t,slot) glds16(ksrc+(long)(t)*KVBLK*DM,(unsigned)__builtin_amdgcn_readfirstlane(kdst+(slot)))
  #define DMA_V(t,slot) glds16(vsrc+(long)(t)*KVBLK*DM,(unsigned)__builtin_amdgcn_readfirstlane(vdst+(slot)))
  const int vb0=(int)(lds0+LDS_V)+((lane>>4)&1)*32+(lane&3)*8+(4*hi+((lane&15)>>2))*64;
  const char*Kbase=shm+LDS_K; bf16x8 kf[8];
  const lds_cptr kp0=shm3+LDS_K+hi*1024+r32*16; const lds_cptr vp0=shm3+LDS_V+((lane>>4)&1)*32+(lane&3)*8+(4*hi+((lane&15)>>2))*64;
  const int NT=(q0+QB)/KVBLK;
  typedef float f32x4_t __attribute__((ext_vector_type(4))); typedef __attribute__((address_space(3))) u32x4 lds_u4; typedef __attribute__((address_space(3))) const bf16x8 lds_cfrag;
  f32x4_t fv_=f32x4_t{}; const bool docp_=COPYF&&(tid*4<q0+QB); if(docp_)fv_=*reinterpret_cast<const f32x4_t*>(Fg+tid*4);
  const float gq_=Fg[q0+wid*QBLK+r32];
  DMA_K(0,0);DMA_V(0,0);DMA_K(1,SLOTB);
  bf16x8 qr[4];
  #pragma unroll
  for(int d0=0;d0<4;++d0)qr[d0]=*reinterpret_cast<const bf16x8*>(&Qw[(long)r32*DM+d0*16+hi*8]);
  float mhat=0.f,l_reg=0.f;f32x16 o[2];o[0]=f32x16{};o[1]=f32x16{};f32x16 negm=f32x16{};asm volatile("":"+v"(negm));
  const int qrel=wid*QBLK+r32;
  #define CMASK(P0,P1,t) do{int jb_=(t)-(NT-4); if(jb_>=0)cmask(P0,P1,jb_,qrel,hi);}while(0)
  bool resc=false;
  #define START(P0,P1) do{ const float rm=rowmax(P0,P1); resc=false; \
    { const float dl=rm; mhat=fadd_s(mhat,dl); \
      _Pragma("unroll") for(int r=0;r<16;++r){P0[r]=fsub_s(P0[r],dl);P1[r]=fsub_s(P1[r],dl);} \
      _Pragma("unroll") for(int r=0;r<16;++r)negm[r]=-mhat; asm volatile("":"+v"(negm)); } \
    _Pragma("unroll") for(int r=0;r<16;++r)P0[r]=__builtin_amdgcn_exp2f(P0[r]); }while(0)
  #define RESC() do{ if(resc){ asm volatile("s_waitcnt lgkmcnt(0)":::"memory"); \
      _Pragma("unroll") for(int d_=0;d_<2;++d_) _Pragma("unroll") for(int r=0;r<16;++r)o[d_][r]*=wsf[crow(r,hi)]; } }while(0)
  f32x16 pA0,pA1,pB0,pB1;
  int sl_prev=0,sl_cur=0,sl_next=SLOTB;
  #define ROT() do{sl_prev=sl_cur;sl_cur=sl_next;sl_next=(sl_next==(NSLOT-1)*SLOTB)?0:sl_next+SLOTB;}while(0)
  DMA_K(2,2*SLOTB);
  #define SPLIT3(x,H,M,L) do{ const unsigned h_=cvtpk_s((x),0.f)&0xffffu; const float r1_=(x)-__uint_as_float(h_<<16); const unsigned m_=cvtpk_s(r1_,0.f)&0xffffu; const float r2_=r1_-__uint_as_float(m_<<16); H=h_; M=m_; L=cvtpk_s(r2_,0.f)&0xffffu; }while(0)
  if(docp_){ _Pragma("unroll") for(int e_=0;e_<4;++e_){ unsigned fh_,fm_,fl_; const float f_=-fv_[e_]; SPLIT3(f_,fh_,fm_,fl_);
      *(lds_u4*)(shm3+LDS_KA+(tid*4+e_)*16)=(u32x4){fh_|(fm_<<16),fl_|0x3f800000u,0x3f803f80u,0u}; } }
  bf16x8 qa; { unsigned gh_,gm_,gl_; SPLIT3(gq_,gh_,gm_,gl_); const u32x4 w_=hi?(u32x4){0u,0u,0u,0u}:(u32x4){0x3f803f80u,0x3f80u|(gh_<<16),gm_|(gl_<<16),0u}; qa=__builtin_bit_cast(bf16x8,w_); }
  #undef SPLIT3
  const lds_cptr kap=shm3+LDS_KA+r32*16;
  WAIT_BAR(3);
  { const bf16x8 ka0s_=*(lds_cfrag*)(kap), ka1s_=*(lds_cfrag*)(kap+512); qkt(pA0,pA1,Kbase,qr,negm,r32,hi,ka0s_,ka1s_,qa); }asm volatile("s_nop 15\n\ts_nop 7":"+v"(pA0),"+v"(pA1));CMASK(pA0,pA1,0);
  START(pA0,pA1);
  _Pragma("unroll") for(int r=0;r<16;++r)pA1[r]=__builtin_amdgcn_exp2f(pA1[r]);
  WAIT_BAR(0);
  DMA_K(3,0);DMA_V(1,SLOTB);
  ROT();
  kload8(kf,kp0+sl_cur);
  WAIT_BAR(2);
  s16x4 vlo[8],vhi[8]; u32x4 pw0,pw1,pw2,pw3;
  #define PKW(P,B) cvtpk_s(P[B],P[B+1])
  #define PAF(k) __builtin_bit_cast(bf16x8,pw##k)
  #define VFR(i) (bf16x8){vlo[i][0],vlo[i][1],vlo[i][2],vlo[i][3],vhi[i][0],vhi[i][1],vhi[i][2],vhi[i][3]}
  #define PIN(x) asm volatile("":"+v"(x))
  #define MX3(a,b,c) __builtin_fmaxf(__builtin_fmaxf((a),(b)),(c))
  #define GAPA(MF,A0,A1,A2,A3,W0,W1,PW) do{ MF; sacc+=A0; sacc+=A1; sacc+=A2; sacc+=A3; PIN(sacc); W0; W1; PIN(PW); SBAR(); }while(0)
  #define EX(v) __builtin_amdgcn_exp2f(v)
  #define GAPB(MF,X,B) do{ MF; X[B]=EX(X[B]); X[B+1]=EX(X[B+1]); X[B+2]=EX(X[B+2]); X[B+3]=EX(X[B+3]); PIN(X); SBAR(); }while(0)
  #define VRD(i) do{ vlo[i]=vtr(vp_+(((i)>>2)*4096+((i)&3)*1024)); vhi[i]=vtr(vp_+(((i)>>2)*4096+((i)&3)*1024+512)); }while(0)
  #define KRD(G,j) do{ if(G){ kload2(kf,kp0+sl_next,j); SBAR(); } }while(0)
  #define STEP(C0,C1,P0,P1,t,GK,GV,GL) do{ SBAR(); \
    const lds_cptr vp_=vp0+sl_prev; const bf16x8 ka0_=*(lds_cfrag*)(kap+(t)*1024), ka1_=*(lds_cfrag*)(kap+(t)*1024+512); \
    VRD(0); SBAR(); float sacc=(P0[0]+P0[1]); \
    GAPA(C0=__builtin_amdgcn_mfma_f32_32x32x16_bf16(kf[0],qr[0],negm,0,0,0), P0[2],P0[3],P0[4],P0[5],     pw0[0]=PKW(P0,0), pw0[1]=PKW(P0,2), pw0); \
    VRD(4); SBAR(); GAPA(C1=__builtin_amdgcn_mfma_f32_32x32x16_bf16(kf[1],qr[0],negm,0,0,0), P0[6],P0[7],P0[8],P0[9],     pw0[2]=PKW(P0,4), pw0[3]=PKW(P0,6), pw0); \
    VRD(1); SBAR(); GAPA(C0=__builtin_amdgcn_mfma_f32_32x32x16_bf16(kf[2],qr[1],C0,0,0,0),   P0[10],P0[11],P0[12],P0[13], pw1[0]=PKW(P0,8), pw1[1]=PKW(P0,10), pw1); \
    VRD(5); SBAR(); GAPA(C1=__builtin_amdgcn_mfma_f32_32x32x16_bf16(kf[3],qr[1],C1,0,0,0),   P0[14],P0[15],P1[0],P1[1],   pw1[2]=PKW(P0,12),pw1[3]=PKW(P0,14), pw1); \
    VRD(2); SBAR(); GAPA(C0=__builtin_amdgcn_mfma_f32_32x32x16_bf16(kf[4],qr[2],C0,0,0,0),   P1[2],P1[3],P1[4],P1[5],     pw2[0]=PKW(P1,0), pw2[1]=PKW(P1,2), pw2); \
    VRD(6); SBAR(); GAPA(C1=__builtin_amdgcn_mfma_f32_32x32x16_bf16(kf[5],qr[2],C1,0,0,0),   P1[6],P1[7],P1[8],P1[9],     pw2[2]=PKW(P1,4), pw2[3]=PKW(P1,6), pw2); \
    VRD(3); SBAR(); GAPA(C0=__builtin_amdgcn_mfma_f32_32x32x16_bf16(kf[6],qr[3],C0,0,0,0),   P1[10],P1[11],P1[12],P1[13], pw3[0]=PKW(P1,8), pw3[1]=PKW(P1,10), pw3); \
    VRD(7); SBAR(); GAPA(C1=__builtin_amdgcn_mfma_f32_32x32x16_bf16(kf[7],qr[3],C1,0,0,0),   P1[14],P1[15],0.f,0.f,       pw3[2]=PKW(P1,12),pw3[3]=PKW(P1,14), pw3); \
    C0=__builtin_amdgcn_mfma_f32_32x32x16_bf16(ka0_,qa,C0,0,0,0); C1=__builtin_amdgcn_mfma_f32_32x32x16_bf16(ka1_,qa,C1,0,0,0); SBAR(); \
    l_reg+=sacc; \
    if(GK){DMA_K((t)+3,sl_cur);} if(GV){DMA_V((t)+1,sl_next);} \
    CMASK(C0,C1,t); \
    { float a=MX3(C0[0],C0[1],C1[0]),b=MX3(C0[2],C0[3],C1[1]); a=MX3(a,C1[2],C1[3]); \
      _Pragma("unroll") for(int r=4;r<16;r+=4){a=MX3(a,C0[r],C0[r+1]);b=MX3(b,C0[r+2],C0[r+3]);a=MX3(a,C1[r],C1[r+1]);b=MX3(b,C1[r+2],C1[r+3]);} \
      float rm=__builtin_fmaxf(a,b); { auto rr=__builtin_amdgcn_permlane32_swap(__float_as_uint(rm),__float_as_uint(rm),false,false); rm=__builtin_fmaxf(__uint_as_float(rr[0]),__uint_as_float(rr[1])); } \
      resc=false; \
      if(__builtin_expect(__any(rm>(float)THRL),0)){ const float dl=__builtin_fmaxf(rm,0.f); mhat+=dl; \
        _Pragma("unroll") for(int r=0;r<16;++r){C0[r]-=dl;C1[r]-=dl;} \
        _Pragma("unroll") for(int r=0;r<16;++r)negm[r]=-mhat; asm volatile("":"+v"(negm)); \
        const float f=__builtin_amdgcn_exp2f(-dl); l_reg*=f; if(hi==0)wsf[r32]=f; resc=true; } } \
    SBAR(); \
    GAPB(o[0]=__builtin_amdgcn_mfma_f32_32x32x16_bf16(PAF(0),VFR(0),o[0],0,0,0), C0,0); \
    GAPB(o[1]=__builtin_amdgcn_mfma_f32_32x32x16_bf16(PAF(0),VFR(4),o[1],0,0,0), C0,4); \
    KRD(GL,0); GAPB(o[0]=__builtin_amdgcn_mfma_f32_32x32x16_bf16(PAF(1),VFR(1),o[0],0,0,0), C0,8); \
    KRD(GL,1); GAPB(o[1]=__builtin_amdgcn_mfma_f32_32x32x16_bf16(PAF(1),VFR(5),o[1],0,0,0), C0,12); \
    KRD(GL,2); GAPB(o[0]=__builtin_amdgcn_mfma_f32_32x32x16_bf16(PAF(2),VFR(2),o[0],0,0,0), C1,0); \
    KRD(GL,3); GAPB(o[1]=__builtin_amdgcn_mfma_f32_32x32x16_bf16(PAF(2),VFR(6),o[1],0,0,0), C1,4); \
    GAPB(o[0]=__builtin_amdgcn_mfma_f32_32x32x16_bf16(PAF(3),VFR(3),o[0],0,0,0), C1,8); \
    GAPB(o[1]=__builtin_amdgcn_mfma_f32_32x32x16_bf16(PAF(3),VFR(7),o[1],0,0,0), C1,12); \
    }while(0)
  int t=1;
  #undef CMASK
  #define CMASK(P0,P1,t) do{}while(0)
  for(;t+5<NT;t+=2){
    STEP(pB0,pB1,pA0,pA1,t,true,true,true);     WAIT_BAR(2); RESC(); ROT();
    STEP(pA0,pA1,pB0,pB1,t+1,true,true,true);   WAIT_BAR(2); RESC(); ROT();
  }
  #undef CMASK
  #define CMASK(P0,P1,t) do{int jb_=(t)-(NT-4); if(jb_>=0)cmask(P0,P1,jb_,qrel,hi);}while(0)
  #define ENDW(tt) do{ if((tt)+3<NT){WAIT_BAR(2);} else if((tt)+2<NT){WAIT_BAR(1);} else {WAIT_BAR(0);} }while(0)
  for(;t+1<NT;t+=2){
    STEP(pB0,pB1,pA0,pA1,t,(t+3<NT),(t+1<NT),(t+1<NT));       ENDW(t);   RESC(); ROT();
    STEP(pA0,pA1,pB0,pB1,t+1,(t+4<NT),(t+2<NT),(t+2<NT));     ENDW(t+1); RESC(); ROT();
  }
  STEP(pB0,pB1,pA0,pA1,NT-1,false,false,false); RESC();
  { float sacc=pB0[0]+pB0[1]; _Pragma("unroll") for(int r=2;r<16;++r)sacc+=pB0[r]; _Pragma("unroll") for(int r=0;r<16;++r)sacc+=pB1[r]; l_reg+=sacc;
    pw0=(u32x4){PKW(pB0,0),PKW(pB0,2),PKW(pB0,4),PKW(pB0,6)};pw1=(u32x4){PKW(pB0,8),PKW(pB0,10),PKW(pB0,12),PKW(pB0,14)};pw2=(u32x4){PKW(pB1,0),PKW(pB1,2),PKW(pB1,4),PKW(pB1,6)};pw3=(u32x4){PKW(pB1,8),PKW(pB1,10),PKW(pB1,12),PKW(pB1,14)};
    SBAR(); pv(o,vb0+sl_cur,PAF(0),PAF(1),PAF(2),PAF(3)); }
  #undef PKW
  #undef PAF
  #undef VFR
  #undef PIN
  #undef MX3
  #undef GAPA
  #undef GAPB
  #undef EX
  #undef VRD
  #undef KRD
  #undef STEP
  #undef ENDW
  {auto rr=__builtin_amdgcn_permlane32_swap(__float_as_uint(l_reg),__float_as_uint(l_reg),false,false);l_reg=__uint_as_float(rr[0])+__uint_as_float(rr[1]);}
  if(hi==0)wsf[32+r32]=l_reg;asm volatile("s_waitcnt lgkmcnt(0)":::"memory");
  float rli[16];
  #pragma unroll
  for(int r=0;r<16;++r)rli[r]=__builtin_amdgcn_rcpf(wsf[32+crow(r,hi)]);
  bf16*Ow=O+(rowbase+q0+wid*QBLK)*OPITCH+h*D; float*sq=ssq+(rowbase+q0+wid*QBLK)*NHEAD+h;
  { bf16*stg=(bf16*)(shm+LDS_OST)+wid*2048;
    #pragma unroll
    for(int r=0;r<16;++r){const int orow=crow(r,hi);
      #pragma unroll
      for(int d0=0;d0<2;++d0)stg[orow*64+d0*32+r32]=__float2bfloat16(o[d0][r]*rli[r]);}
    asm volatile("s_waitcnt lgkmcnt(0)":::"memory");
    #pragma unroll
    for(int i=0;i<4;++i){const int row=i*8+(lane>>3),ch=lane&7; const u32x4 v=*(const u32x4*)(stg+row*64+ch*8); ATTN_STORE16(Ow+(long)row*OPITCH+ch*8,v);
      float s2=0.f; _Pragma("unroll") for(int e=0;e<4;++e){ const float lo_=__uint_as_float(v[e]<<16), hi_=__uint_as_float(v[e]&0xffff0000u); s2+=lo_*lo_+hi_*hi_; }
      s2+=__shfl_xor(s2,1); s2+=__shfl_xor(s2,2); s2+=__shfl_xor(s2,4); if(ch==0)sq[(long)row*NHEAD]=s2; } }
  asm volatile("s_waitcnt lgkmcnt(0)\n\ts_barrier":::"memory");
  #undef DMA_K
  #undef DMA_V
  #undef CMASK
  #undef START
  #undef RESC
  #undef ROT
}
constexpr int ATTN_LDS_BYTES=LDS_BYTES;
#undef SBAR
#undef WAIT_BAR
}
namespace hg {
#define HLAS __attribute__((address_space(3)))
typedef short bf16x8 __attribute__((ext_vector_type(8)));
typedef short v4i16_t __attribute__((ext_vector_type(4)));
typedef float f32x16 __attribute__((ext_vector_type(16)));
typedef float f32x4 __attribute__((ext_vector_type(4)));
typedef unsigned u32x4 __attribute__((ext_vector_type(4)));
typedef float f32x2_t __attribute__((ext_vector_type(2))); typedef __bf16 bf16x2_t __attribute__((ext_vector_type(2)));
typedef unsigned short bf16_t;
__device__ __forceinline__ unsigned cvtpk(float lo, float hi) { f32x2_t v = {lo, hi}; bf16x2_t b = __builtin_convertvector(v, bf16x2_t); return __builtin_bit_cast(unsigned, b); }
__device__ __forceinline__ unsigned off_b(unsigned row, unsigned ch) { return 272u * row + 16u * ch; }
__device__ __forceinline__ int crow(int reg, int h) { return (reg & 3) + 8 * (reg >> 2) + 4 * h; }
__device__ __forceinline__ bf16x8 pack8(const f32x16& x, int s) {
    u32x4 p; p.x = cvtpk(x[8 * s], x[8 * s + 1]); p.y = cvtpk(x[8 * s + 2], x[8 * s + 3]); p.z = cvtpk(x[8 * s + 4], x[8 * s + 5]); p.w = cvtpk(x[8 * s + 6], x[8 * s + 7]);
    return __builtin_bit_cast(bf16x8, p);
}
__device__ __forceinline__ v4i16_t trd(HLAS const unsigned char* p) { return __builtin_amdgcn_ds_read_tr16_b64_v4i16((HLAS v4i16_t*)p); }
__device__ __forceinline__ void glds16(const void* gsrc, unsigned lds_dst) { unsigned keep;
    asm volatile("s_mov_b32 %0, m0\n\ts_mov_b32 m0, %2\n\ts_nop 0\n\tglobal_load_lds_dwordx4 %1, off\n\ts_mov_b32 m0, %0" : "=&s"(keep) : "v"(gsrc), "s"(lds_dst) : "memory"); }
__device__ __forceinline__ unsigned off_v(unsigned row, unsigned ch) { return 256u * row + 16u * ch; }
#define HMFMA(a, b, c) __builtin_amdgcn_mfma_f32_32x32x16_bf16((a), (b), (c), 0, 0, 0)
#define HG_BAR() do { asm volatile("s_waitcnt lgkmcnt(0)" ::: "memory"); __builtin_amdgcn_s_barrier(); asm volatile("" ::: "memory"); } while (0)
constexpr int IMG_ONE = 64 * 272, IMG_QT = 0, IMG_QP = IMG_ONE, IMG_KH = 2 * IMG_ONE, IMG_VV = 3 * IMG_ONE, IMG_BYTES = 4 * IMG_ONE, AUX_BYTES = 2560, OB_PITCH = 132;
constexpr int NCH = 32, CH = 64, PITCH = 512, OPITCH = 1024;

__device__ __forceinline__ void hgrn_unit(int unit, const bf16_t* QF, const bf16_t* KK, const bf16_t* VI, const bf16_t* GH, bf16_t* OC, HLAS unsigned char* lds, HLAS unsigned char* aux0) {
    int tid_ = threadIdx.x; asm volatile("" : "+v"(tid_));
    const int tid = tid_, lane = tid & 63, wid = __builtin_amdgcn_readfirstlane(tid >> 6), role = wid >> 2, gw = wid & 3, gt = tid & 255;
    const int bh = unit, b = bh >> 2, h = bh & 3, r32 = lane & 31, hh = lane >> 5;
    const size_t rowbase = (size_t)b * 2048; const int cb = h * 128;
    const int blk = (lane >> 4) & 1, tq = (lane & 15) >> 2, tp = lane & 3;
#define HG_DMA_V(c) do { const bf16_t* vs_ = VI + (rowbase + (size_t)(c) * CH + 16 * gw + (lane >> 4)) * PITCH + cb + 8 * (lane & 15); const unsigned vdst0 = (unsigned)(size_t)(img + IMG_VV) + (unsigned)(16 * gw) * 256u; \
        _Pragma("unroll") for (int j = 0; j < 4; ++j) glds16(vs_ + (size_t)(4 * j) * PITCH, (unsigned)__builtin_amdgcn_readfirstlane(vdst0 + 1024u * j)); } while (0)
#define HG_LOAD_RAW(KD, QD, c) do { const size_t r0_ = rowbase + (size_t)(c) * CH; \
        _Pragma("unroll") for (int i = 0; i < 16; ++i) { const size_t o_ = (r0_ + 16 * gw + i) * PITCH + cb + 2 * lane; KD[i] = *(const unsigned*)(KK + o_); QD[i] = *(const unsigned*)(QF + o_); } \
        } while (0)
    if (role == 0) {
        unsigned kk2[16], qf2[16], kkn[16], qfn[16];
#pragma unroll
        for (int i = 0; i < 16; ++i) { kkn[i] = 0u; qfn[i] = 0u; }
        HG_LOAD_RAW(kk2, qf2, 0);
        for (int s = 0; s <= NCH; ++s) {
            HLAS unsigned char* img = lds + (s & 1) * IMG_BYTES;
            HLAS float* segtot = (HLAS float*)(aux0 + (s & 1) * AUX_BYTES); HLAS float* dec = segtot + 512;
            float bl0[16], bl1[16]; float a0 = 0.f, a1 = 0.f;
            if (s < NCH) {
                HG_DMA_V(s);
                if (s + 1 < NCH) HG_LOAD_RAW(kkn, qfn, s + 1);
        a0 = 0.f; a1 = 0.f;
#pragma unroll
        for (int i = 0; i < 16; ++i) { const float k0 = __uint_as_float(kk2[i] << 16), k1 = __uint_as_float(kk2[i] & 0xffff0000u);
            a0 += __builtin_amdgcn_logf(fmaxf(1.0f - k0, 1e-30f)); a1 += __builtin_amdgcn_logf(fmaxf(1.0f - k1, 1e-30f)); bl0[i] = a0; bl1[i] = a1; }
        *(HLAS f32x2_t*)(segtot + gw * 128 + 2 * lane) = (f32x2_t){a0, a1};
            }
            HG_BAR();
            if (s < NCH) {
        float p0 = 0.f, p1 = 0.f, t0 = 0.f, t1 = 0.f;
#pragma unroll
        for (int w = 0; w < 4; ++w) { const f32x2_t s = *(HLAS const f32x2_t*)(segtot + w * 128 + 2 * lane); if (w < gw) { p0 += s.x; p1 += s.y; } t0 += s.x; t1 += s.y; }
        const float ei0 = __builtin_amdgcn_exp2f(fminf(-t0, 115.f)), ei1 = __builtin_amdgcn_exp2f(fminf(-t1, 115.f));
        if (gw == 0) *(HLAS f32x2_t*)(dec + 2 * lane) = (f32x2_t){__builtin_amdgcn_exp2f(t0), __builtin_amdgcn_exp2f(t1)};
        {
            const int k = 2 * lane, k16 = k & 15, ng = (((k16 >> 2) & 1) << 1) | (k16 >> 3), pos = (k & ~15) + (ng << 2) + (k16 & 3);
            const unsigned chn = (unsigned)(k >> 3), bn = (unsigned)((k & 7) * 2), chp = (unsigned)(pos >> 3), bp = (unsigned)((pos & 7) * 2);
#pragma unroll
            for (int i = 0; i < 16; ++i) { const unsigned row = 16 * gw + i;
                const float k0 = __uint_as_float(kk2[i] << 16), k1 = __uint_as_float(kk2[i] & 0xffff0000u), q0 = __uint_as_float(qf2[i] << 16), q1 = __uint_as_float(qf2[i] & 0xffff0000u);
                const float e0 = __builtin_amdgcn_exp2f(p0 + bl0[i]), e1 = __builtin_amdgcn_exp2f(p1 + bl1[i]);
                const float l0 = fminf(fmaxf(e0 * ei0, 1e-30f), 1e30f), l1 = fminf(fmaxf(e1 * ei1, 1e-30f), 1e30f);
                *(HLAS unsigned*)(img + IMG_QT + off_b(row, chp) + bp) = cvtpk(q0 * e0, q1 * e1);
                *(HLAS unsigned*)(img + IMG_QP + off_b(row, chn) + bn) = cvtpk(q0 * l0, q1 * l1);
                *(HLAS unsigned*)(img + IMG_KH + off_b(row, chn) + bn) = cvtpk(k0 * __builtin_amdgcn_rcpf(l0), k1 * __builtin_amdgcn_rcpf(l1)); }
        }
                asm volatile("s_waitcnt vmcnt(0)" ::: "memory");
#pragma unroll
                for (int i = 0; i < 16; ++i) { kk2[i] = kkn[i]; qf2[i] = qfn[i]; }
            }
            HG_BAR();
        }
    } else {
        f32x16 S[4];
#pragma unroll
        for (int i = 0; i < 4; ++i) S[i] = f32x16{};
        u32x4 g16[4]; f32x16 o[2];
#pragma unroll
        for (int j = 0; j < 4; ++j) g16[j] = (u32x4){0u, 0u, 0u, 0u};
        o[0] = f32x16{}; o[1] = f32x16{};
        for (int s = 0; s <= NCH + 1; ++s) {
            if (s >= 2) { const int c = s - 2; HLAS float* OB = (HLAS float*)(lds + (c & 1) * IMG_BYTES);
        { const int t = gt >> 2, qd = gt & 3; f32x4 ov[8]; float ss = 0.f;
#pragma unroll
          for (int j = 0; j < 8; ++j) { ov[j] = *(HLAS const f32x4*)(OB + t * OB_PITCH + 32 * qd + 4 * j); ss += (ov[j][0] * ov[j][0] + ov[j][1] * ov[j][1]) + (ov[j][2] * ov[j][2] + ov[j][3] * ov[j][3]); }
          ss += __shfl_xor(ss, 1); ss += __shfl_xor(ss, 2);
          const float rs = 1.0f / sqrtf(ss * (1.0f / 128.0f) + 1e-6f);
          bf16_t* op = OC + (rowbase + (size_t)c * CH + t) * OPITCH + 512 + cb + 32 * qd;
#pragma unroll
          for (int j = 0; j < 4; ++j) { u32x4 w;
#pragma unroll
              for (int e = 0; e < 4; ++e) { const float ga = __uint_as_float(g16[j][e] << 16), gb = __uint_as_float(g16[j][e] & 0xffff0000u);
                  const int f = 2 * e; const f32x4 va = ov[2 * j + (f >> 2)];
                  w[e] = cvtpk(va[f & 3] * rs * ga, va[(f & 3) + 1] * rs * gb); }
              *(u32x4*)(op + 8 * j) = w; } }
            }
            if (s > NCH) break;
            HLAS unsigned char* img = lds + ((s - 1) & 1) * IMG_BYTES; HLAS float* dec = (HLAS float*)(aux0 + ((s - 1) & 1) * AUX_BYTES) + 512; HLAS float* OB = (HLAS float*)img;
            if (s >= 1) { const int c = s - 1;
        { const size_t r0 = rowbase + (size_t)c * CH + (gt >> 2);
#pragma unroll
          for (int j = 0; j < 4; ++j) g16[j] = *(const u32x4*)(GH + r0 * PITCH + cb + 32 * (gt & 3) + 8 * j); }
        o[0] = f32x16{}; o[1] = f32x16{};
#pragma unroll
        for (int kb = 0; kb < 4; ++kb) { const bf16x8 sb0 = pack8(S[kb], 0), sb1 = pack8(S[kb], 1);
#pragma unroll
            for (int tb = 0; tb < 2; ++tb) {
                const bf16x8 a0f = *(HLAS const bf16x8*)(img + IMG_QT + off_b(32 * tb + r32, 4 * kb + hh));
                const bf16x8 a1f = *(HLAS const bf16x8*)(img + IMG_QT + off_b(32 * tb + r32, 4 * kb + 2 + hh));
                o[tb] = HMFMA(a0f, sb0, o[tb]); o[tb] = HMFMA(a1f, sb1, o[tb]); }
            __builtin_amdgcn_sched_barrier(0); }
#pragma unroll
        for (int tb = 0; tb < 2; ++tb)
#pragma unroll
            for (int sb = 0; sb <= tb; ++sb) { f32x16 X = f32x16{};
#pragma unroll
                for (int ks = 0; ks < 8; ++ks) { const bf16x8 af = *(HLAS const bf16x8*)(img + IMG_KH + off_b(32 * sb + r32, 2 * ks + hh)), bf = *(HLAS const bf16x8*)(img + IMG_QP + off_b(32 * tb + r32, 2 * ks + hh));
                    X = HMFMA(af, bf, X); }
                if (sb == tb) {
#pragma unroll
                    for (int r = 0; r < 16; ++r) if (crow(r, hh) > r32) X[r] = 0.f; }
#pragma unroll
                for (int ss = 0; ss < 2; ++ss) { const bf16x8 xa = pack8(X, ss);
                    const unsigned rw = 32 * sb + 16 * ss + 4 * hh + tq;
                    const v4i16_t lo = trd(img + IMG_VV + off_v(rw, 4 * gw + 2 * blk + (tp >> 1)) + 8 * (tp & 1)), hi = trd(img + IMG_VV + off_v(rw + 8, 4 * gw + 2 * blk + (tp >> 1)) + 8 * (tp & 1));
                    const bf16x8 vb = (bf16x8){lo[0], lo[1], lo[2], lo[3], hi[0], hi[1], hi[2], hi[3]};
                    o[tb] = HMFMA(xa, vb, o[tb]); }
                __builtin_amdgcn_sched_barrier(0); }
#pragma unroll
        for (int kb = 0; kb < 4; ++kb)
#pragma unroll
            for (int g4 = 0; g4 < 4; ++g4) { const f32x4 d = *(HLAS const f32x4*)(dec + 32 * kb + 8 * g4 + 4 * hh);
#pragma unroll
                for (int e = 0; e < 4; ++e) S[kb][4 * g4 + e] *= d[e]; }
#pragma unroll
        for (int ss = 0; ss < 4; ++ss) { const unsigned rw = 16 * ss + 8 * hh + tq;
            const v4i16_t vlo = trd(img + IMG_VV + off_v(rw, 4 * gw + 2 * blk + (tp >> 1)) + 8 * (tp & 1)), vhi = trd(img + IMG_VV + off_v(rw + 4, 4 * gw + 2 * blk + (tp >> 1)) + 8 * (tp & 1));
            const bf16x8 vb = (bf16x8){vlo[0], vlo[1], vlo[2], vlo[3], vhi[0], vhi[1], vhi[2], vhi[3]};
#pragma unroll
            for (int kb = 0; kb < 4; ++kb) {
                const v4i16_t klo = trd(img + IMG_KH + off_b(rw, 4 * kb + 2 * blk + (tp >> 1)) + 8 * (tp & 1)), khi = trd(img + IMG_KH + off_b(rw + 4, 4 * kb + 2 * blk + (tp >> 1)) + 8 * (tp & 1));
                const bf16x8 ka = (bf16x8){klo[0], klo[1], klo[2], klo[3], khi[0], khi[1], khi[2], khi[3]};
                S[kb] = HMFMA(ka, vb, S[kb]); }
            __builtin_amdgcn_sched_barrier(0); }
            }
            HG_BAR();
            if (s >= 1) {
#pragma unroll
        for (int tb = 0; tb < 2; ++tb)
#pragma unroll
            for (int r = 0; r < 16; ++r) OB[(32 * tb + crow(r, hh)) * OB_PITCH + 32 * gw + r32] = o[tb][r];
            }
            HG_BAR();
        }
    }
    __syncthreads();
#undef HG_LOAD_RAW
#undef HG_DMA_V
}
#undef HMFMA
#undef HG_BAR
}
#define GAS __attribute__((address_space(1)))
#define LAS __attribute__((address_space(3)))
typedef unsigned short bf16;
typedef unsigned v4u __attribute__((ext_vector_type(4)));
typedef float f32x4 __attribute__((ext_vector_type(4)));
constexpr int T_ = 65536, D_ = 1024, FF_ = 2816, SEQ_ = 2048, NB_ = 32, NMOD_ = 9216, NMIX_ = 3584;
constexpr size_t MiB = 1u << 20;
constexpr size_t WS_CTL = 0, WS_MOD = 2 * MiB, WS_WFG = 4 * MiB, WS_LF = 5 * MiB, WS_SSQ = 7 * MiB, WS_FL2 = 9 * MiB - 0 * MiB;
constexpr size_t WS_W1IN = 12 * MiB, WS_W1OUT = 23 * MiB, WS_WMIX = 29 * MiB, WS_WOUT = 36 * MiB, WS_W2IN = 38 * MiB, WS_W2OUT = 49 * MiB;
constexpr size_t WS_XN = 64 * MiB, WS_H = 192 * MiB, WS_X2 = 640 * MiB, WS_XN2 = 896 * MiB, WS_END = 1024 * MiB;
constexpr size_t SEGSTRIDE = (size_t)T_ * 512;
static_assert(WS_FL2 + 2 * MiB <= WS_W1IN && WS_W2OUT + 6 * MiB <= WS_XN, "ws map");
constexpr int RING_BYTES = 131072, MISC_OFF = 2 * hg::IMG_BYTES, HG_AUX_OFF = MISC_OFF + 1024, LDS_BYTES = 147456;
static_assert(HG_AUX_OFF + 2 * hg::AUX_BYTES <= LDS_BYTES && attn_body::ATTN_LDS_BYTES <= RING_BYTES, "LDS map");
constexpr float LOG2E = 1.4426950408889634f;

struct Frame {
    LAS unsigned char* lds; volatile LAS unsigned* MISC;
    int tid, lane, wave, G;
    const float* in[19]; float* out; unsigned char* ws;
};
__device__ __forceinline__ float wave_sum(float v) {
#pragma unroll
    for (int o = 1; o < 64; o <<= 1) v += __shfl_xor(v, o);
    return v;
}
__device__ __forceinline__ unsigned f2bf(float f) { unsigned u = __builtin_bit_cast(unsigned, f); return (u + 0x7fffu + ((u >> 16) & 1u)) >> 16; }
__device__ __forceinline__ unsigned pk2(float lo, float hi) { return f2bf(lo) | (f2bf(hi) << 16); }
#define LDS_WAIT() asm volatile("s_waitcnt lgkmcnt(0)" ::: "memory")
#define XB_TMO      128
#define XB_XCNT(j)  (256  + 64 * (j))
#define XB_XSUB(j)  (1280 + 64 * (j))
#define XB_XGEN(j)  (2304 + 64 * (j))
#define XB_TOP      3328
#define XB_TOPGEN   3392
#define XCD_BAR_WORDS 3456
#define XB_SPIN_CAP (1u << 18)

__device__ __forceinline__ unsigned xb_ld(unsigned* p)              { return __hip_atomic_load(p, __ATOMIC_RELAXED, __HIP_MEMORY_SCOPE_AGENT); }
__device__ __forceinline__ unsigned xb_add(unsigned* p, unsigned v) { return __hip_atomic_fetch_add(p, v, __ATOMIC_RELAXED, __HIP_MEMORY_SCOPE_AGENT); }
__device__ __forceinline__ unsigned xb_xcc_id() { return (unsigned)__builtin_amdgcn_s_getreg((3 << 11) | 20) & 0xFu; }
#define XB_SPIN(cond, bar) do { unsigned _sp = 0; while (cond) { __builtin_amdgcn_s_sleep(1); \
    if ((++_sp & 255u) == 0u) { if (xb_ld(&(bar)[XB_TMO])) break; if (_sp > XB_SPIN_CAP) { atomicAdd(&(bar)[XB_TMO], 1u); break; } } } } while (0)

struct XcdBarrier {
    unsigned* bar; unsigned x;
    volatile LAS unsigned* st;
};

__device__ __forceinline__ XcdBarrier xcd_barrier_post(unsigned* bar, volatile LAS unsigned* st) {
    XcdBarrier b; b.bar = bar; b.x = xb_xcc_id(); b.st = st;
    if (threadIdx.x == 0) (void)xb_add(&bar[XB_XCNT(b.x)], 1u);
    return b;
}
__device__ __forceinline__ void xcd_barrier_complete(unsigned* bar, unsigned x, unsigned& nloc, unsigned& nx) {
    const unsigned G = gridDim.x * gridDim.y * gridDim.z;
    unsigned sum, cnt, mine, sp = 0u;
    for (;;) {
        sum = 0u; cnt = 0u; mine = 0u;
#pragma unroll
        for (unsigned j = 0; j < 16; ++j) { const unsigned c = xb_ld(&bar[XB_XCNT(j)]); sum += c; cnt += (c > 0u) ? 1u : 0u; mine = (j == x) ? c : mine; }
        if (sum == G) break;
        __builtin_amdgcn_s_sleep(1);
        if ((++sp & 255u) == 0u) { if (xb_ld(&bar[XB_TMO])) break; if (sp > XB_SPIN_CAP) { atomicAdd(&bar[XB_TMO], 1u); break; } }
    }
    nloc = mine > 0u ? mine : 1u; nx = cnt > 0u ? cnt : 1u;
}

__device__ __forceinline__ void xcd_barrier(const XcdBarrier& b) {
    asm volatile("s_waitcnt vmcnt(0)" ::: "memory");
    __syncthreads();
    if (threadIdx.x == 0) {
        unsigned* bar = b.bar;
        __builtin_amdgcn_s_waitcnt(0);
        unsigned nloc = b.st[0], nx = b.st[1];
        if (nloc == 0u) { xcd_barrier_complete(bar, b.x, nloc, nx); b.st[0] = nloc; b.st[1] = nx; }
        const unsigned old = xb_add(&bar[XB_XSUB(b.x)], 1u);
        const unsigned gen = old / nloc;
        if (old + 1u == (gen + 1u) * nloc) {
            __builtin_amdgcn_fence(__ATOMIC_RELEASE, "agent");
            asm volatile("s_waitcnt vmcnt(0)" ::: "memory");
            const unsigned og = xb_add(&bar[XB_TOP], 1u);
            const unsigned tg = og / nx;
            if (og + 1u == (tg + 1u) * nx) xb_add(&bar[XB_TOPGEN], 1u);
            else XB_SPIN(xb_ld(&bar[XB_TOPGEN]) == tg, bar);
            __builtin_amdgcn_fence(__ATOMIC_ACQUIRE, "agent");
            xb_add(&bar[XB_XGEN(b.x)], 1u);
            asm volatile("s_waitcnt vmcnt(0)" ::: "memory");
        } else {
            XB_SPIN(xb_ld(&bar[XB_XGEN(b.x)]) == gen, bar);
            __builtin_amdgcn_fence(__ATOMIC_ACQUIRE, "agent");
            asm volatile("s_waitcnt vmcnt(0)" ::: "memory");
        }
    }
    __syncthreads();
}

__device__ __forceinline__ void tr_item(const float* W, int ldw, int K, int k0, int n_src0, bf16* WT, int dst_row0, const float* ka, const float* kb, LAS float* scr, int lane) {
    float wv[32];
#pragma unroll
    for (int i = 0; i < 32; ++i) wv[i] = W[(size_t)(k0 + 2 * i + (lane >> 5)) * ldw + n_src0 + (lane & 31)];
#pragma unroll
    for (int i = 0; i < 32; ++i) { const int kk = 2 * i + (lane >> 5); float w = wv[i];
        if (ka) { const int k = k0 + kk; w *= (k < 512) ? ka[k] : kb[k - 512]; }
        scr[kk * 33 + (lane & 31)] = w; }
    LDS_WAIT(); asm volatile("" ::: "memory");
    const int c = lane & 7;
#pragma unroll
    for (int j = 0; j < 4; ++j) { const int n = (lane >> 3) + 8 * j; const LAS float* s = scr + (8 * c) * 33 + n;
        v4u o; o.x = pk2(s[0 * 33], s[1 * 33]); o.y = pk2(s[2 * 33], s[3 * 33]); o.z = pk2(s[4 * 33], s[5 * 33]); o.w = pk2(s[6 * 33], s[7 * 33]);
        *(v4u*)(WT + (size_t)(dst_row0 + n) * K + k0 + 8 * c) = o; }
    LDS_WAIT(); asm volatile("" ::: "memory");
}
__device__ __forceinline__ void p0_ffn_in_item(const float* W, bf16* WT, int r, LAS float* scr, int lane) {
    const int kb = r / 176, nb = r % 176, ns = 32 * nb; int dst;
    if (ns < FF_) dst = 256 * (ns / 128) + (ns % 128); else { const int c = ns - FF_; dst = 256 * (c / 128) + 128 + (c % 128); }
    tr_item(W, 2 * FF_, D_, 64 * kb, ns, WT, dst, nullptr, nullptr, scr, lane);
}
__device__ __forceinline__ void p0_mix_item(const float* W, bf16* WT, int r, LAS float* scr, int lane) {
    const int kb = r / 112, db = r % 112, seg = db >> 4, t = 32 * (db & 15), half = t >> 8, tt = t & 255;
    int feat = t; if (seg < 2) { const int bj = tt >> 7, wc = (tt & 127) >> 5; feat = 256 * half + 64 * wc + 32 * bj; }
    const int srcb = (seg < 3) ? 512 * seg : 1544 + 512 * (seg - 3);
    tr_item(W, 3592, D_, 64 * kb, srcb + feat, WT, 32 * db, nullptr, nullptr, scr, lane);
}
constexpr int P0_I_IN = 16 * 176, P0_I_OUT = 44 * 32, P0_I_MIX = 16 * 112, P0_I_WO = 16 * 32, P0_NITEMS = 2 * P0_I_IN + 2 * P0_I_OUT + P0_I_MIX + P0_I_WO;
__device__ __forceinline__ void p0_item(Frame& F, int it, LAS float* scr) {
    int r = it;
    if (r < P0_I_IN) { p0_ffn_in_item(F.in[5], (bf16*)(F.ws + WS_W1IN), r, scr, F.lane); return; } r -= P0_I_IN;
    if (r < P0_I_IN) { p0_ffn_in_item(F.in[17], (bf16*)(F.ws + WS_W2IN), r, scr, F.lane); return; } r -= P0_I_IN;
    if (r < P0_I_OUT) { tr_item(F.in[6], D_, FF_, 64 * (r / 32), 32 * (r % 32), (bf16*)(F.ws + WS_W1OUT), 32 * (r % 32), nullptr, nullptr, scr, F.lane); return; } r -= P0_I_OUT;
    if (r < P0_I_OUT) { tr_item(F.in[18], D_, FF_, 64 * (r / 32), 32 * (r % 32), (bf16*)(F.ws + WS_W2OUT), 32 * (r % 32), nullptr, nullptr, scr, F.lane); return; } r -= P0_I_OUT;
    if (r < P0_I_MIX) { p0_mix_item(F.in[8], (bf16*)(F.ws + WS_WMIX), r, scr, F.lane); return; } r -= P0_I_MIX;
    tr_item(F.in[15], D_, D_, 64 * (r / 32), 32 * (r % 32), (bf16*)(F.ws + WS_WOUT), 32 * (r % 32), F.in[12], F.in[14], scr, F.lane);
}
__device__ __forceinline__ void p0_prologue(Frame& F0) {
    Frame F = F0; { int t_ = threadIdx.x; asm volatile("" : "+v"(t_)); F.tid = t_; F.lane = t_ & 63; }
    float* mod = (float*)(F.ws + WS_MOD);
    for (int item = blockIdx.x; item < NMOD_ / 64; item += F.G) {
        LAS float* cs = (LAS float*)F.lds;
        for (int i = F.tid; i < NB_ * D_; i += 512) { const float c = F.in[1][i]; cs[i] = c / (1.0f + __expf(-c)); }
        __syncthreads();
        const int col = item * 64 + F.lane, k0 = F.wave * 128;
        float acc[32];
#pragma unroll
        for (int b = 0; b < 32; ++b) acc[b] = 0.f;
        const float* wp = F.in[2] + (size_t)k0 * NMOD_ + col;
#pragma unroll 1
        for (int k = 0; k < 128; k += 8) {
            float w[8];
#pragma unroll
            for (int j = 0; j < 8; ++j) w[j] = wp[(size_t)(k + j) * NMOD_];
#pragma unroll
            for (int b = 0; b < 32; ++b) { const f32x4 c4 = *(const LAS f32x4*)(cs + b * D_ + k0 + k); acc[b] += (c4[0] * w[0] + c4[1] * w[1]) + (c4[2] * w[2] + c4[3] * w[3]); }
            asm volatile("" ::: "memory");
#pragma unroll
            for (int b = 0; b < 32; ++b) { const f32x4 c4 = *(const LAS f32x4*)(cs + b * D_ + k0 + k + 4); acc[b] += (c4[0] * w[4] + c4[1] * w[5]) + (c4[2] * w[6] + c4[3] * w[7]); }
            asm volatile("" ::: "memory");
        }
        __syncthreads();
        LAS float* red = cs;
#pragma unroll
        for (int b = 0; b < 32; ++b) red[(F.wave * 32 + b) * 64 + F.lane] = acc[b];
        __syncthreads();
        for (int o = F.tid; o < 2048; o += 512) { const int b = o >> 6, l = o & 63; float s = 0.f;
#pragma unroll
            for (int w = 0; w < 8; ++w) s += red[(w * 32 + b) * 64 + l];
            mod[(size_t)b * NMOD_ + item * 64 + l] = s + F.in[3][item * 64 + l]; }
        __syncthreads();
    }
    { float* wfg = (float*)(F.ws + WS_WFG); const int gi = blockIdx.x * 512 + F.tid;
      for (int i = gi; i < 8 * D_; i += F.G * 512) wfg[i] = F.in[8][(size_t)(i & 1023) * 3592 + 1536 + (i >> 10)]; }
    LAS float* scr = (LAS float*)(F.lds + F.wave * 16384);
    const int gw = blockIdx.x * 8 + F.wave, NGW = F.G * 8;
    constexpr int NITEMS = P0_NITEMS, NA = 6912;
    if (F.G > NMOD_ / 64 + 16) {
        for (int it = gw; it < NA; it += NGW) p0_item(F, it, scr);
        if ((int)blockIdx.x >= NMOD_ / 64) { const int gw2 = ((int)blockIdx.x - NMOD_ / 64) * 8 + F.wave, NGW2 = (F.G - NMOD_ / 64) * 8;
            for (int it = NA + gw2; it < NITEMS; it += NGW2) p0_item(F, it, scr); }
    } else for (int it = gw; it < NITEMS; it += NGW) p0_item(F, it, scr);
}
template <bool SRCB> __device__ __forceinline__ f32x4 ld_row4(const float* src, size_t e) {
    if (!SRCB) return __builtin_nontemporal_load((const f32x4*)(src + e));
    const unsigned long long w = *(const unsigned long long*)((const bf16*)src + e); const unsigned lo = (unsigned)w, hi = (unsigned)(w >> 32);
    return (f32x4){__uint_as_float(lo << 16), __uint_as_float(lo & 0xffff0000u), __uint_as_float(hi << 16), __uint_as_float(hi & 0xffff0000u)};
}
template <int MODE, bool SRCB> __device__ __forceinline__ void norm_phase(Frame& F0, const float* src, const float* g, int sh_chunk, int sc_chunk) {
    Frame F = F0; { int t_ = threadIdx.x; asm volatile("" : "+v"(t_)); F.tid = t_; F.lane = t_ & 63; }
    const float* mod = (const float*)(F.ws + WS_MOD); bf16* XN = (bf16*)(F.ws + WS_XN);
    LAS float* wl = (LAS float*)F.lds;
    if (MODE == 1) { const float* wfg = (const float*)(F.ws + WS_WFG); for (int i = F.tid; i < 8 * D_; i += 512) wl[i] = wfg[i]; __syncthreads(); }
    const int gw = blockIdx.x * 8 + F.wave, NGW = F.G * 8;
    for (int r0 = gw * 32; r0 < T_; r0 += NGW * 32) {
        const int b = r0 / SEQ_; const float* mp = mod + (size_t)b * NMOD_;
        f32x4 A[4], Bv[4];
#pragma unroll
        for (int j = 0; j < 4; ++j) { const int col = 4 * F.lane + 256 * j; const f32x4 gg = *(const f32x4*)(g + col), sc = *(const f32x4*)(mp + sc_chunk * D_ + col);
            A[j] = gg * (sc + 1.0f); Bv[j] = *(const f32x4*)(mp + sh_chunk * D_ + col); }
        f32x4 nv[4];
#pragma unroll
        for (int j = 0; j < 4; ++j) nv[j] = ld_row4<SRCB>(src, (size_t)r0 * D_ + 4 * F.lane + 256 * j);
        for (int r = r0; r < r0 + 32; ++r) {
            f32x4 v[4]; float ss = 0.f;
#pragma unroll
            for (int j = 0; j < 4; ++j) { v[j] = nv[j]; ss += (v[j][0] * v[j][0] + v[j][1] * v[j][1]) + (v[j][2] * v[j][2] + v[j][3] * v[j][3]); }
            if (r + 1 < r0 + 32) {
#pragma unroll
                for (int j = 0; j < 4; ++j) nv[j] = ld_row4<SRCB>(src, (size_t)(r + 1) * D_ + 4 * F.lane + 256 * j); }
            const float rstd = 1.0f / sqrtf(wave_sum(ss) * (1.0f / D_) + 1e-6f);
#pragma unroll
            for (int j = 0; j < 4; ++j) { v[j] = v[j] * rstd * A[j] + Bv[j];
                *(unsigned long long*)(XN + (size_t)r * D_ + 4 * F.lane + 256 * j) = (unsigned long long)pk2(v[j][0], v[j][1]) | ((unsigned long long)pk2(v[j][2], v[j][3]) << 32); }
            if (MODE == 1) {
                float d[8];
#pragma unroll
                for (int h = 0; h < 8; ++h) { float s = 0.f;
#pragma unroll
                    for (int j = 0; j < 4; ++j) { const f32x4 w = *(const LAS f32x4*)(wl + h * D_ + 4 * F.lane + 256 * j); s += (v[j][0] * w[0] + v[j][1] * w[1]) + (v[j][2] * w[2] + v[j][3] * w[3]); }
                    d[h] = wave_sum(s); }
                float z = d[0];
#pragma unroll
                for (int h = 1; h < 8; ++h) z = (F.lane == h) ? d[h] : z;
                if (F.lane < 8) { z += F.in[9][F.lane]; ((float*)(F.ws + WS_LF))[(size_t)r * 8 + F.lane] = fminf(z, 0.f) - __logf(1.0f + __expf(-fabsf(z))); }
            }
        }
    }
    if (MODE == 1) __syncthreads();
}
__device__ __forceinline__ void fscan_phase(Frame& F0) {
    Frame F = F0; { int t_ = threadIdx.x; asm volatile("" : "+v"(t_)); F.tid = t_; F.lane = t_ & 63; }
    const float* LF = (const float*)(F.ws + WS_LF); float* FL2 = (float*)(F.ws + WS_FL2);
    LAS float* wsum = (LAS float*)F.lds;
    for (int bh = blockIdx.x; bh < 256; bh += F.G) { const int b = bh >> 3, h = bh & 7;
        float p[4]; float a = 0.f;
#pragma unroll
        for (int i = 0; i < 4; ++i) { a += LF[((size_t)b * SEQ_ + 4 * F.tid + i) * 8 + h]; p[i] = a; }
        float incl = a;
#pragma unroll
        for (int o = 1; o < 64; o <<= 1) { const float t = __shfl_up(incl, o); if (F.lane >= o) incl += t; }
        if (F.lane == 63) wsum[F.wave] = incl;
        __syncthreads();
        float woff = 0.f;
#pragma unroll
        for (int w = 0; w < 8; ++w) woff += (w < F.wave) ? wsum[w] : 0.f;
        const float ex = woff + incl - a;
        f32x4 o4; o4[0] = (ex + p[0]) * LOG2E; o4[1] = (ex + p[1]) * LOG2E; o4[2] = (ex + p[2]) * LOG2E; o4[3] = (ex + p[3]) * LOG2E;
        *(f32x4*)(FL2 + (size_t)bh * SEQ_ + 4 * F.tid) = o4;
        __syncthreads();
    }
}

#ifndef PHASE_MASK
#define PHASE_MASK 0x7ff
#endif
#ifndef P6SEL
#define P6SEL 0
#endif
#ifndef REPEAT_MASK
#define REPEAT_MASK 0
#endif
#define PH(k) if constexpr (((PHASE_MASK) >> (k)) & 1) for (int rep_ = 0; rep_ < 1 + (((REPEAT_MASK) >> (k)) & 1); ++rep_)
struct Args { const float* in[19]; float* out; unsigned char* ws; int pad0, pad1; };
__global__ void __launch_bounds__(512, 2) fwd_mega(Args args) {
    extern __shared__ __attribute__((aligned(16))) unsigned char lds[];
    cg::grid_group grid = cg::this_grid();
    Frame F;
    F.lds = (LAS unsigned char*)lds; F.MISC = (volatile LAS unsigned*)(F.lds + MISC_OFF);
    F.tid = threadIdx.x; F.lane = F.tid & 63; F.wave = __builtin_amdgcn_readfirstlane(F.tid >> 6); F.G = gridDim.x;
#pragma unroll
    for (int i = 0; i < 19; ++i) F.in[i] = args.in[i];
    F.out = args.out; F.ws = args.ws;
    unsigned char* ws = args.ws;
    float* mod = (float*)(ws + WS_MOD);
    bf16* XN = (bf16*)(ws + WS_XN); bf16* HB = (bf16*)(ws + WS_H); bf16* PJ = (bf16*)(ws + WS_H); float* X2 = (float*)(ws + WS_X2);
    const int bid = (int)blockIdx.x;
    if (threadIdx.x < 16) F.MISC[threadIdx.x] = 0u;
    __syncthreads();
    const XcdBarrier xbar = xcd_barrier_post((unsigned*)(ws + WS_CTL + 16384), F.MISC + 8);
#define GSYNC() xcd_barrier(xbar)

    PH(0) p0_prologue(F);
    grid.sync();
#ifdef SYNC_PROBE
    for (int i_ = 0; i_ < 20; ++i_) grid.sync();
#endif
    PH(1) norm_phase<0, false>(F, F.in[0], F.in[4], 0, 1);
    GSYNC();
    PH(2) { pg8::Gemm g{XN, (const bf16*)(ws + WS_W1IN), T_, 2 * FF_, D_}; pg8::StaticOrder S; S.init(T_, 2 * FF_, F.G, bid);
      pg8::EpiSwiGLU E{HB, FF_};
      pg8::gemm_phase<pg8::EpiSwiGLU, pg8::StaticOrder, true, true>(F.lds, g, S, E); }
    GSYNC();
    PH(3) { pg8::Gemm g{HB, (const bf16*)(ws + WS_W1OUT), T_, D_, FF_, 1}; pg8::StaticOrder S; S.init(T_, D_, F.G, bid);
      pg8::EpiResid<false> E{F.in[0], F.out, mod + 2 * D_, 0.5f, nullptr};
      pg8::gemm_phase<pg8::EpiResid<false>, pg8::StaticOrder, true, true>(F.lds, g, S, E); }
    GSYNC();
    PH(4) norm_phase<1, false>(F, F.out, F.in[7], 3, 4);
    GSYNC();
    PH(5) fscan_phase(F);
    PH(5) { pg8::Gemm g{XN, (const bf16*)(ws + WS_WMIX), T_, NMIX_, D_}; pg8::StaticOrder S; S.init(T_, NMIX_, F.G, bid);
      pg8::EpiMix E{PJ, SEGSTRIDE, F.in[10], F.in[11], F.in[13], attn_body::C2};
      pg8::gemm_phase<pg8::EpiMix, pg8::StaticOrder, true, true>(F.lds, g, S, E); }
    GSYNC();
    PH(6) {
        const int xl = bid & 7;
        unsigned* q = (unsigned*)(ws + WS_CTL) + 1024 * rep_ + 64 * xl;
        const attn_body::bf16* Qp = (const attn_body::bf16*)PJ; const attn_body::bf16* Kp = Qp + SEGSTRIDE; const attn_body::bf16* Vp = Qp + 2 * SEGSTRIDE;
        for (;;) {
            if (threadIdx.x == 0) F.MISC[0] = atomicAdd(q, 1u);
            __syncthreads();
            const int idx = (int)F.MISC[0];
            __syncthreads();
            if (idx >= 16 + 256) break;
            if (idx < 16) { if (!(rep_ == 1 && P6SEL >= 2)) hg::hgrn_unit(xl + 8 * idx, PJ + 3 * SEGSTRIDE, PJ + 4 * SEGSTRIDE, PJ + 5 * SEGSTRIDE, PJ + 6 * SEGSTRIDE, XN, F.lds, F.lds + HG_AUX_OFF); }
            else if (!(rep_ == 1 && P6SEL == 1)) { const int a = idx - 16, bh = xl + 8 * (a & 31), qb = 7 - (a >> 5);
                const float* Fg = (const float*)(ws + WS_FL2) + (size_t)bh * SEQ_;
                attn_body::attn_unit<90, true>(bh >> 3, bh & 7, qb, Qp, Kp, Vp, (attn_body::bf16*)XN, Fg, (float*)(ws + WS_SSQ), (char*)lds); }
        }
    }
    GSYNC();
    PH(7) { pg8::Gemm g{XN, (const bf16*)(ws + WS_WOUT), T_, D_, D_}; pg8::StaticOrder S; S.init(T_, D_, F.G, bid);
      typedef pg8::EpiResidNorm<true> EN; static_assert(EN::O_MOD == WS_MOD && EN::O_LF == WS_LF && EN::O_SSQ == WS_SSQ && EN::O_XN2 == WS_XN2 && EN::O_CNT == WS_CTL + 65536, "fused-norm epilogue vs the workspace map");
      pg8::EpiResidNorm<true> E{F.out, X2, ws, F.in[16], 1.0f};
      pg8::gemm_phase<pg8::EpiResidNorm<true>, pg8::StaticOrder, true, true>(F.lds, g, S, E); }
    GSYNC();
    PH(9) { pg8::Gemm g{(const bf16*)(ws + WS_XN2), (const bf16*)(ws + WS_W2IN), T_, 2 * FF_, D_}; pg8::StaticOrder S; S.init(T_, 2 * FF_, F.G, bid);
      pg8::EpiSwiGLU E{HB, FF_};
      pg8::gemm_phase<pg8::EpiSwiGLU, pg8::StaticOrder, true, true>(F.lds, g, S, E); }
    GSYNC();
    PH(10) { pg8::Gemm g{HB, (const bf16*)(ws + WS_W2OUT), T_, D_, FF_, 1}; pg8::StaticOrder S; S.init(T_, D_, F.G, bid);
      pg8::EpiResid<false> E{X2, F.out, mod + 8 * D_, 0.5f, nullptr};
      pg8::gemm_phase<pg8::EpiResid<false>, pg8::StaticOrder, true, true>(F.lds, g, S, E); }
}

extern "C" void kernel_launch(void* const* d_in, const int* in_sizes, int n_in, void* d_out, int out_size, void* d_ws, size_t ws_size, hipStream_t stream) {
    static int grid = 0;
    if (grid == 0) {
        int dev = 0, cus = 0, per_cu = 0;
        if (n_in != 19 || out_size != T_ * D_ || ws_size < WS_END) { fprintf(stderr, "kernel_launch: unexpected shapes (n_in %d out %d ws %zu)\n", n_in, out_size, ws_size); grid = -1; return; }
        (void)hipGetDevice(&dev);
        (void)hipDeviceGetAttribute(&cus, hipDeviceAttributeMultiprocessorCount, dev);
        (void)hipFuncSetAttribute((const void*)fwd_mega, hipFuncAttributeMaxDynamicSharedMemorySize, LDS_BYTES);
        (void)hipOccupancyMaxActiveBlocksPerMultiprocessor(&per_cu, (const void*)fwd_mega, 512, LDS_BYTES);
        (void)hipGetLastError();
        grid = cus > 0 ? cus : 256;
        fprintf(stderr, "kernel_launch: cus %d per_cu %d grid %d ws %zu\n", cus, per_cu, grid, ws_size);
    }
    if (grid < 0) return;
    (void)hipMemsetAsync((char*)d_ws + WS_CTL, 0, 131072, stream);
    Args a{};
    for (int i = 0; i < 19; ++i) a.in[i] = (const float*)d_in[i];
    a.out = (float*)d_out; a.ws = (unsigned char*)d_ws;
    void* args[] = {&a};
    hipError_t e = hipLaunchCooperativeKernel((const void*)fwd_mega, dim3(grid), dim3(512), args, LDS_BYTES, stream);
    if (e != hipSuccess) fprintf(stderr, "cooperative launch failed: %s (grid %d)\n", hipGetErrorString(e), grid);
}
```

```cpp
#include <hip/hip_runtime.h>
#include <hip/hip_cooperative_groups.h>
#include <cstdio>
#include <cstdint>
namespace cg = cooperative_groups;
namespace pg8 {
#define PG8_LAS __attribute__((address_space(3)))
typedef unsigned short bf16_t;
typedef short bf16x8 __attribute__((ext_vector_type(8)));
typedef float f32x4 __attribute__((ext_vector_type(4)));
typedef unsigned u32x4 __attribute__((ext_vector_type(4)));
constexpr int BM = 256, BK = 64, HALF = 128, HTB = HALF * BK * 2  , STAGE_BYTES = 8 * HTB, NXCD = 8, WGM = 4;

__host__ __device__ __forceinline__ int lds_byte(int r, int c) { const int st = (r >> 4) * 2 + (c >> 5), rr = r & 15, cc = c & 31, ob = rr * 64 + cc * 2; return st * 1024 + (ob ^ (((ob >> 9) & 1) << 5)); }
__host__ __device__ __forceinline__ void stage_rc(int b, int& R, int& C) { const int st = b / 1024, sb = b % 1024, swz = sb ^ (((sb >> 9) & 1) << 5); R = (st >> 1) * 16 + swz / 64; C = (st & 1) * 32 + (swz % 64) / 2; }
__host__ __device__ __forceinline__ int perm32(int rho) { const int n = rho >> 4, i = rho & 15; return 8 * (i >> 2) + 4 * n + (i & 3); }

struct Unit { int pm, pn; };
struct Gemm { const bf16_t* A; const bf16_t* Bt; int M, N, K; int atile; };

struct StaticOrder {
    int nM, nN, nwg, G, c;
    __host__ __device__ void init(int M, int N, int G_, int c_) { nM = M / BM; nN = N / BM; nwg = nM * nN; G = G_; c = c_; }
    __host__ __device__ bool next(int i, Unit& u) const {
        const long L = (long)i * G + c; if (L >= nwg) return false;
        int wgid = (int)L; { const int q = nwg / NXCD, r = nwg % NXCD, xcd = wgid % NXCD, off = wgid / NXCD; wgid = (xcd < r ? xcd * (q + 1) : r * (q + 1) + (xcd - r) * q) + off; }
        const int nig = WGM * nN, gid = wgid / nig, fm = gid * WGM, gsz = (nM - fm) < WGM ? (nM - fm) : WGM;
        u.pm = fm + ((wgid % nig) % gsz); u.pn = (wgid % nig) / gsz; return true;
    }
    __device__ __forceinline__ void a_ready(const Unit&) const {}
    __device__ __forceinline__ void done(const Unit&) const {}
};

__device__ __forceinline__ unsigned cvt_pk_bf16(float lo, float hi) { unsigned r; asm volatile("v_cvt_pk_bf16_f32 %0, %1, %2" : "=v"(r) : "v"(lo), "v"(hi)); return r; }
typedef float f32x2 __attribute__((ext_vector_type(2)));
__device__ __forceinline__ float silu_f(float x) { return x * __builtin_amdgcn_rcpf(1.0f + __expf(-x)); }
struct EpiSwiGLU {
    static constexpr bool PERM = true, AFTER_DRAIN = false, MID = false; static constexpr int MID_T = -1; static constexpr bool SPLIT = true, FUSEDN = false;
    bf16_t* O; int ldc;
    __device__ __forceinline__ void mid(f32x4 (&)[2][2][4][2], const Unit&, int, int) const {}
    __device__ __forceinline__ void operator()(const f32x4 (&acc)[2][2][4][2], const Unit& u, int wr, int wc, int fr, int fq) const {
        const int ln = fr + 16 * fq, srcl = 4 * ((ln >> 2) + 16 * (ln & 3));
        bf16_t* blk0 = O + ((size_t)(u.pm * 16 + wr * 4) * (ldc >> 5) + u.pn * 4 + wc) * 512 + ln * 8;
#pragma unroll
        for (int ai = 0; ai < 2; ++ai)
#pragma unroll
            for (int m = 0; m < 4; ++m) { bf16_t* p = blk0 + (size_t)(ai * 8 + m) * (ldc >> 5) * 512;
                const f32x4 g0 = acc[ai][0][m][0], g1 = acc[ai][0][m][1], u0 = acc[ai][1][m][0], u1 = acc[ai][1][m][1];
                u32x4 w; w.x = cvt_pk_bf16(silu_f(g0[0]) * u0[0], silu_f(g0[1]) * u0[1]); w.y = cvt_pk_bf16(silu_f(g0[2]) * u0[2], silu_f(g0[3]) * u0[3]);
                w.z = cvt_pk_bf16(silu_f(g1[0]) * u1[0], silu_f(g1[1]) * u1[1]); w.w = cvt_pk_bf16(silu_f(g1[2]) * u1[2], silu_f(g1[3]) * u1[3]);
                u32x4 wp; wp.x = (unsigned)__builtin_amdgcn_ds_bpermute(srcl, (int)w.x); wp.y = (unsigned)__builtin_amdgcn_ds_bpermute(srcl, (int)w.y); wp.z = (unsigned)__builtin_amdgcn_ds_bpermute(srcl, (int)w.z); wp.w = (unsigned)__builtin_amdgcn_ds_bpermute(srcl, (int)w.w);
                __builtin_nontemporal_store(wp, (u32x4*)p); }
    }
};
template <bool MIDF> struct EpiResid {
    static constexpr bool PERM = true, AFTER_DRAIN = false, MID = MIDF; static constexpr int MID_T = 8; static constexpr bool SPLIT = false, FUSEDN = false;
    const float* base; float* out; const float* gate; float coef; const float* ssq;
    __device__ __forceinline__ void mid(f32x4 (&acc)[2][2][4][2], const Unit& u, int wr, int fr) const {
#pragma unroll
        for (int ai = 0; ai < 2; ++ai)
#pragma unroll
            for (int m = 0; m < 4; ++m) { const size_t row = (size_t)(u.pm * BM + ai * HALF + wr * 64 + m * 16 + fr);
                const f32x4 a = *(const f32x4*)(ssq + row * 8), b = *(const f32x4*)(ssq + row * 8 + 4);
                const float s = ((a[0] + a[1]) + (a[2] + a[3])) + ((b[0] + b[1]) + (b[2] + b[3]));
                const float rs = 1.0f / sqrtf(s * (1.0f / 512.0f) + 1e-6f);
#pragma unroll
                for (int bj = 0; bj < 2; ++bj)
#pragma unroll
                    for (int n = 0; n < 2; ++n) acc[ai][bj][m][n] = acc[ai][bj][m][n] * rs; }
    }
    __device__ __forceinline__ void operator()(const f32x4 (&acc)[2][2][4][2], const Unit& u, int wr, int wc, int fr, int fq) const {
        const int b = u.pm >> 3; const float* gp = gate + (size_t)b * 9216; const int col0 = u.pn * BM + wc * 32 + 8 * fq;
        f32x4 gv[2][2];
#pragma unroll
        for (int bj = 0; bj < 2; ++bj)
#pragma unroll
            for (int n = 0; n < 2; ++n) gv[bj][n] = *(const f32x4*)(gp + col0 + bj * HALF + n * 4) * coef;
#pragma unroll
        for (int ai = 0; ai < 2; ++ai)
#pragma unroll
            for (int m = 0; m < 4; ++m) { const size_t off = (size_t)(u.pm * BM + ai * HALF + wr * 64 + m * 16 + fr) * 1024 + col0;
#pragma unroll
                for (int bj = 0; bj < 2; ++bj)
#pragma unroll
                    for (int n = 0; n < 2; ++n) { const f32x4 bs = *(const f32x4*)(base + off + bj * HALF + n * 4); *(f32x4*)(out + off + bj * HALF + n * 4) = bs + gv[bj][n] * acc[ai][bj][m][n]; }
                if (m & 1) asm volatile("" ::: "memory"); }
    }
};
template <bool MIDF> struct EpiResidNorm {
    static constexpr bool PERM = true, AFTER_DRAIN = false, MID = MIDF; static constexpr int MID_T = 8; static constexpr bool SPLIT = false, FUSEDN = true;
    const float* base; float* out; unsigned char* ws; const float* gn; float coef;
    static constexpr size_t O_MOD = (size_t)2 << 20, O_LF = (size_t)5 << 20, O_SSQ = (size_t)7 << 20, O_XN2 = (size_t)896 << 20, O_CNT = 65536;
    static constexpr int C_GATE = 5, C_SH = 6, C_SC = 7;
    __device__ __forceinline__ void mid(f32x4 (&acc)[2][2][4][2], const Unit& u, int wr, int fr_) const {
        int fr = fr_; asm volatile("" : "+v"(fr));
#pragma unroll
        for (int ai = 0; ai < 2; ++ai)
#pragma unroll
            for (int m = 0; m < 4; ++m) { const size_t row = (size_t)(u.pm * BM + ai * HALF + wr * 64 + m * 16 + fr);
                const float* ssq = (const float*)(ws + O_SSQ); const f32x4 a = *(const f32x4*)(ssq + row * 8), b = *(const f32x4*)(ssq + row * 8 + 4);
                const float s = ((a[0] + a[1]) + (a[2] + a[3])) + ((b[0] + b[1]) + (b[2] + b[3]));
                const float rs = 1.0f / sqrtf(s * (1.0f / 512.0f) + 1e-6f);
#pragma unroll
                for (int bj = 0; bj < 2; ++bj)
#pragma unroll
                    for (int n = 0; n < 2; ++n) acc[ai][bj][m][n] = acc[ai][bj][m][n] * rs; }
    }
    __device__ __forceinline__ void fusedn(f32x4 (&acc)[2][2][4][2], const Unit& u, int wr, int wc, int fr_, int fq_, PG8_LAS unsigned char* lds, int wid, int lane_) const {
        int fr = fr_, fq = fq_, lane = lane_; asm volatile("" : "+v"(fr), "+v"(fq), "+v"(lane));
        PG8_LAS float* P = (PG8_LAS float*)(lds + 140288);
        PG8_LAS float* S = P + 1024;
        const int b = u.pm >> 3; const float* modb = (const float*)(ws + O_MOD) + (size_t)b * 9216; const float* gp = modb + C_GATE * 1024; const int col0 = u.pn * BM + wc * 32 + 8 * fq;
        unsigned* slots = (unsigned*)(ws + O_LF); unsigned* cnt = (unsigned*)(ws + O_CNT); bf16_t* xn = (bf16_t*)(ws + O_XN2);
        f32x4 gv[2][2];
#pragma unroll
        for (int bj = 0; bj < 2; ++bj)
#pragma unroll
            for (int n = 0; n < 2; ++n) gv[bj][n] = *(const f32x4*)(gp + col0 + bj * HALF + n * 4) * coef;
#pragma unroll
        for (int ai = 0; ai < 2; ++ai)
#pragma unroll
            for (int m = 0; m < 4; ++m) { const size_t off = (size_t)(u.pm * BM + ai * HALF + wr * 64 + m * 16 + fr) * 1024 + col0; float s = 0.f;
#pragma unroll
                for (int bj = 0; bj < 2; ++bj)
#pragma unroll
                    for (int n = 0; n < 2; ++n) { const f32x4 bs = *(const f32x4*)(base + off + bj * HALF + n * 4); const f32x4 o = bs + gv[bj][n] * acc[ai][bj][m][n];
                        acc[ai][bj][m][n] = o; s += (o[0] * o[0] + o[1] * o[1]) + (o[2] * o[2] + o[3] * o[3]); }
                s += __shfl_xor(s, 16); s += __shfl_xor(s, 32);
                if (fq == 0) P[(ai * HALF + wr * 64 + m * 16 + fr) * 4 + wc] = s;
                asm volatile("" ::: "memory"); }
        asm volatile("s_waitcnt lgkmcnt(0)" ::: "memory"); __builtin_amdgcn_s_barrier(); asm volatile("" ::: "memory");
        const int row = wid * 32 + (lane & 31);
        if (lane < 32) { const f32x4 p = *(const PG8_LAS f32x4*)(P + row * 4);
            __hip_atomic_store(slots + ((size_t)(u.pm * BM + row) * 4 + u.pn), __float_as_uint((p[0] + p[1]) + (p[2] + p[3])), __ATOMIC_RELAXED, __HIP_MEMORY_SCOPE_AGENT); }
        asm volatile("s_waitcnt vmcnt(0)" ::: "memory");
        if (lane == 0) __hip_atomic_fetch_add(cnt + 64 * u.pm, 1u, __ATOMIC_RELAXED, __HIP_MEMORY_SCOPE_AGENT);
#pragma unroll
        for (int ai = 0; ai < 2; ++ai)
#pragma unroll
            for (int m = 0; m < 4; ++m) { const size_t off = (size_t)(u.pm * BM + ai * HALF + wr * 64 + m * 16 + fr) * 1024 + col0;
#pragma unroll
                for (int bj = 0; bj < 2; ++bj)
#pragma unroll
                    for (int n = 0; n < 2; ++n) *(f32x4*)(out + off + bj * HALF + n * 4) = acc[ai][bj][m][n]; }
        if (wid == 0) { unsigned sp = 0;
            while ((unsigned)__builtin_amdgcn_readfirstlane(__hip_atomic_load(cnt + 64 * u.pm, __ATOMIC_RELAXED, __HIP_MEMORY_SCOPE_AGENT)) < 32u) { __builtin_amdgcn_s_sleep(2); if (++sp > (1u << 24)) break; }
            __builtin_amdgcn_fence(__ATOMIC_ACQUIRE, "agent"); }
        asm volatile("s_waitcnt vmcnt(0) lgkmcnt(0)" ::: "memory"); __builtin_amdgcn_s_barrier(); asm volatile("" ::: "memory");
        if (lane < 32) { const unsigned* sl = slots + (size_t)(u.pm * BM + row) * 4; float t = 0.f;
#pragma unroll
            for (int k = 0; k < 4; ++k) t += __uint_as_float(__hip_atomic_load(sl + k, __ATOMIC_RELAXED, __HIP_MEMORY_SCOPE_AGENT));
            S[row] = 1.0f / sqrtf(t * (1.0f / 1024.0f) + 1e-6f); }
        asm volatile("s_waitcnt lgkmcnt(0)" ::: "memory"); __builtin_amdgcn_s_barrier(); asm volatile("" ::: "memory");
#pragma unroll
        for (int bj = 0; bj < 2; ++bj) { f32x4 An[2], Bn[2];
#pragma unroll
            for (int n = 0; n < 2; ++n) { const int c = col0 + bj * HALF + n * 4; const f32x4 g4 = *(const f32x4*)(gn + c), s4 = *(const f32x4*)(modb + C_SC * 1024 + c);
                An[n] = g4 * (s4 + 1.0f); Bn[n] = *(const f32x4*)(modb + C_SH * 1024 + c); }
#pragma unroll
            for (int ai = 0; ai < 2; ++ai)
#pragma unroll
                for (int m = 0; m < 4; ++m) { const int rl = ai * HALF + wr * 64 + m * 16 + fr; const float r = S[rl]; const size_t off = (size_t)(u.pm * BM + rl) * 1024 + col0;
                    const f32x4 v0 = acc[ai][bj][m][0] * r * An[0] + Bn[0], v1 = acc[ai][bj][m][1] * r * An[1] + Bn[1];
                    u32x4 w; w.x = cvt_pk_bf16(v0[0], v0[1]); w.y = cvt_pk_bf16(v0[2], v0[3]); w.z = cvt_pk_bf16(v1[0], v1[1]); w.w = cvt_pk_bf16(v1[2], v1[3]);
                    *(u32x4*)(xn + off + bj * HALF) = w; }
            asm volatile("" ::: "memory"); }
    }
};
struct EpiMix {
    static constexpr bool PERM = true, AFTER_DRAIN = false, MID = false; static constexpr int MID_T = -1; static constexpr bool SPLIT = false, FUSEDN = false;
    bf16_t* P; size_t segstride; const float* qg; const float* kg; const float* lbl; float c2;
    __device__ __forceinline__ void mid(f32x4 (&)[2][2][4][2], const Unit&, int, int) const {}
    __device__ __forceinline__ void operator()(const f32x4 (&acc)[2][2][4][2], const Unit& u, int wr, int wc, int fr, int fq) const {
        const int seg = u.pn >> 1, half = u.pn & 1;
        bf16_t* base = P + (size_t)seg * segstride + (size_t)(u.pm * BM + wr * 64 + fr) * 512 + 256 * half;
        if (seg < 2) {
            const float* g = seg == 0 ? qg : kg; const float sc = seg == 0 ? c2 : 1.0f;
            f32x4 gn[2][2];
#pragma unroll
            for (int bj = 0; bj < 2; ++bj)
#pragma unroll
                for (int n = 0; n < 2; ++n) gn[bj][n] = *(const f32x4*)(g + 32 * bj + 8 * fq + 4 * n) * sc;
#pragma unroll
            for (int ai = 0; ai < 2; ++ai)
#pragma unroll
                for (int m = 0; m < 4; ++m) { float ss = 0.f;
#pragma unroll
                    for (int bj = 0; bj < 2; ++bj)
#pragma unroll
                        for (int n = 0; n < 2; ++n) { const f32x4 x = acc[ai][bj][m][n]; ss += (x[0] * x[0] + x[1] * x[1]) + (x[2] * x[2] + x[3] * x[3]); }
                    ss += __shfl_xor(ss, 16); ss += __shfl_xor(ss, 32);
                    const float rs = 1.0f / sqrtf(ss * (1.0f / 64.0f) + 1e-6f);
#pragma unroll
                    for (int bj = 0; bj < 2; ++bj) { const f32x4 v0 = acc[ai][bj][m][0] * gn[bj][0] * rs, v1 = acc[ai][bj][m][1] * gn[bj][1] * rs;
                        u32x4 w; w.x = cvt_pk_bf16(v0[0], v0[1]); w.y = cvt_pk_bf16(v0[2], v0[3]); w.z = cvt_pk_bf16(v1[0], v1[1]); w.w = cvt_pk_bf16(v1[2], v1[3]);
                        *(u32x4*)(base + (size_t)(ai * HALF + m * 16) * 512 + 64 * wc + 32 * bj + 8 * fq) = w; } }
        } else {
            const int cw = wc * 32 + 8 * fq;
            f32x4 om[2][2];
#pragma unroll
            for (int bj = 0; bj < 2; ++bj)
#pragma unroll
                for (int n = 0; n < 2; ++n) { om[bj][n] = (f32x4){1.f, 1.f, 1.f, 1.f};
                    if (seg == 4) { const int c = 256 * half + 128 * bj + cw + 4 * n; const f32x4 l0 = *(const f32x4*)(lbl + c), l1 = *(const f32x4*)(lbl + 512 + c);
#pragma unroll
                        for (int e = 0; e < 4; ++e) om[bj][n][e] = __builtin_amdgcn_rcpf(1.0f + __expf(l0[e] - l1[e])); } }
#pragma unroll
            for (int ai = 0; ai < 2; ++ai)
#pragma unroll
                for (int m = 0; m < 4; ++m)
#pragma unroll
                    for (int bj = 0; bj < 2; ++bj) { f32x4 v0 = acc[ai][bj][m][0], v1 = acc[ai][bj][m][1];
                        if (seg == 3 || seg == 6) {
#pragma unroll
                            for (int e = 0; e < 4; ++e) { v0[e] = silu_f(v0[e]); v1[e] = silu_f(v1[e]); }
                        } else if (seg == 4) {
#pragma unroll
                            for (int e = 0; e < 4; ++e) { v0[e] = om[bj][0][e] * __builtin_amdgcn_rcpf(1.0f + __expf(v0[e])); v1[e] = om[bj][1][e] * __builtin_amdgcn_rcpf(1.0f + __expf(v1[e])); }
                        }
                        u32x4 w; w.x = cvt_pk_bf16(v0[0], v0[1]); w.y = cvt_pk_bf16(v0[2], v0[3]); w.z = cvt_pk_bf16(v1[0], v1[1]); w.w = cvt_pk_bf16(v1[2], v1[3]);
                        if (seg >= 3) __builtin_nontemporal_store(w, (u32x4*)(base + (size_t)(ai * HALF + m * 16) * 512 + 128 * bj + cw));
                        else *(u32x4*)(base + (size_t)(ai * HALF + m * 16) * 512 + 128 * bj + cw) = w; }
        }
    }
};
template <class Epi, class Sched, bool ALIGN_EPI = false, bool SP2 = false>
__device__ __forceinline__ void gemm_phase(PG8_LAS unsigned char* lds, const Gemm g, const Sched& S, const Epi& E) {
    int tid_ = threadIdx.x; asm volatile("" : "+v"(tid_));
    const int tid = tid_, wid = __builtin_amdgcn_readfirstlane(tid >> 6), lane = tid & 63, wr = wid >> 2, wc = wid & 3, fr = lane & 15, fq = lane >> 4;
    const int K = g.K, nt = K / BK;
    unsigned voffA[2], voffB[2];
#pragma unroll
    for (int i = 0; i < 2; ++i) { int R, C; stage_rc(tid * 16 + i * 8192, R, C); const int Rb = Epi::PERM ? ((R & ~31) + perm32(R & 31)) : R;
        voffA[i] = g.atile ? (unsigned)(((R >> 4) * (K >> 5) + (C >> 5)) * 1024 + ((R & 15) * 4 + ((C & 31) >> 3)) * 16) : (unsigned)(R * K + C) * 2u;
        voffB[i] = (unsigned)(Rb * K + C) * 2u; }
    const size_t kstep = (size_t)(BK * 2);
    const size_t hstep = (size_t)HALF * K * 2;
    const size_t tstep = 2 * hstep;
    const size_t kstepA = g.atile ? (size_t)2048 : kstep, hstepA = g.atile ? (size_t)8 * (K >> 5) * 1024 : hstep, tstepA = 2 * hstepA;
    const unsigned ldsw = (unsigned)wid * 1024u;
    const int aoff = lds_byte(wr * 64 + fr, fq * 8), boff = lds_byte(wc * 32 + fr, fq * 8);
#define PG8_SA(b, h) (((b) * 2 + (h)) * HTB)
#define PG8_SB(b, h) ((4 + (b) * 2 + (h)) * HTB)
#define PG8_STAGE(bufoff, gbase, voff) do { _Pragma("unroll") for (int _i = 0; _i < 2; ++_i) \
        __builtin_amdgcn_global_load_lds((const unsigned*)((const char*)(gbase) + (voff)[_i]), (PG8_LAS unsigned*)(lds + (bufoff) + ldsw + _i * 8192), 16, 0, 0); } while (0)
#define PG8_LDA(dst, b, h) do { _Pragma("unroll") for (int m = 0; m < 4; ++m) _Pragma("unroll") for (int k = 0; k < 2; ++k) dst[m][k] = *(const PG8_LAS bf16x8*)(lds + PG8_SA(b, h) + aoff + m * 2048 + k * 1024); } while (0)
#define PG8_LDB(dst, b, h) do { _Pragma("unroll") for (int n = 0; n < 2; ++n) _Pragma("unroll") for (int k = 0; k < 2; ++k) dst[n][k] = *(const PG8_LAS bf16x8*)(lds + PG8_SB(b, h) + boff + n * 2048 + k * 1024); } while (0)
#define PG8_MMA(ai, bj, At, Bt) do { __builtin_amdgcn_s_setprio(1); _Pragma("unroll") for (int m = 0; m < 4; ++m) _Pragma("unroll") for (int n = 0; n < 2; ++n) _Pragma("unroll") for (int k = 0; k < 2; ++k) \
        acc[ai][bj][m][n] = __builtin_amdgcn_mfma_f32_16x16x32_bf16(Bt[n][k], At[m][k], acc[ai][bj][m][n], 0, 0, 0); __builtin_amdgcn_s_setprio(0); } while (0)
#define PG8_WAIT_V(n) asm volatile("s_waitcnt vmcnt(" #n ")" ::: "memory")
#define PG8_WAIT_V_UNLESS(n, flag) asm volatile("s_cmp_lg_u32 %0, 0\n\ts_cbranch_scc1 .Lpg8skip%=\n\ts_waitcnt vmcnt(" #n ")\n.Lpg8skip%=:" :: "s"(flag) : "memory", "scc")
#define PG8_WAIT_L(n) asm volatile("s_waitcnt lgkmcnt(" #n ")" ::: "memory")
#define PG8_BAR __builtin_amdgcn_s_barrier()
#define PG8_SCHED __builtin_amdgcn_sched_barrier(0)
    Unit cur, nxt; int ui = 0;
    if (!S.next(0, cur)) return;
    f32x4 acc[2][2][4][2];
#pragma unroll
    for (int a = 0; a < 2; ++a)
#pragma unroll
        for (int b = 0; b < 2; ++b)
#pragma unroll
            for (int m = 0; m < 4; ++m)
#pragma unroll
                for (int n = 0; n < 2; ++n) acc[a][b][m][n] = (f32x4){0.f, 0.f, 0.f, 0.f};
    bf16x8 At[4][2], B0[2][2], B1[2][2];
    const char* cA = (const char*)g.A + (size_t)cur.pm * tstepA; const char* cB = (const char*)g.Bt + (size_t)cur.pn * tstep;
    S.a_ready(cur);
    if constexpr (SP2) {
        PG8_STAGE(PG8_SB(0, 0), cB, voffB); PG8_STAGE(PG8_SB(0, 1), cB + hstep, voffB); PG8_STAGE(PG8_SA(0, 0), cA, voffA); PG8_STAGE(PG8_SA(0, 1), cA + hstepA, voffA);
        if (wr == 1) PG8_BAR;
        PG8_WAIT_V(2); PG8_BAR;
        PG8_STAGE(PG8_SB(1, 0), cB + kstep, voffB); PG8_STAGE(PG8_SA(1, 0), cA + kstepA, voffA); PG8_STAGE(PG8_SB(1, 1), cB + hstep + kstep, voffB);
        PG8_WAIT_V(6); PG8_BAR;
    } else {
        PG8_STAGE(PG8_SB(0, 0), cB, voffB); PG8_STAGE(PG8_SA(0, 0), cA, voffA); PG8_STAGE(PG8_SB(0, 1), cB + hstep, voffB); PG8_STAGE(PG8_SA(0, 1), cA + hstepA, voffA);
        if (wr == 1) PG8_BAR;
        PG8_WAIT_V(4); PG8_BAR;
        PG8_STAGE(PG8_SB(1, 0), cB + kstep, voffB); PG8_STAGE(PG8_SA(1, 0), cA + kstepA, voffA); PG8_STAGE(PG8_SB(1, 1), cB + hstep + kstep, voffB);
        PG8_WAIT_V(6); PG8_BAR;
    }
    for (;;) {
        const bool has_next = S.next(ui + 1, nxt);
        const char* nA = has_next ? (const char*)g.A + (size_t)nxt.pm * tstepA : cA; const char* nB = has_next ? (const char*)g.Bt + (size_t)nxt.pn * tstep : cB;
        for (int t = 0; t < nt; t += 2) {
            if constexpr (Epi::MID) { if (t == Epi::MID_T) E.mid(acc, cur, wr, fr); }
            const bool last = (t == nt - 2);
            const char* a1 = cA + (size_t)(t + 1) * kstepA;
            const char* a2 = last ? nA : cA + (size_t)(t + 2) * kstepA; const char* b2 = last ? nB : cB + (size_t)(t + 2) * kstep;
            const char* a3 = a2 + kstepA; const char* b3 = b2 + kstep;
            if (last && has_next) S.a_ready(nxt);
            const int skipw = __builtin_amdgcn_readfirstlane((Epi::SPLIT && t == 0 && ui > 0) ? 1 : 0);
            if constexpr (SP2) {
            PG8_LDB(B0, 0, 0); PG8_LDB(B1, 0, 1); PG8_SCHED; PG8_LDA(At, 0, 0); PG8_STAGE(PG8_SA(1, 1), a1 + hstepA, voffA);
            PG8_WAIT_V_UNLESS(8, skipw); PG8_WAIT_L(0); PG8_BAR; PG8_MMA(0, 0, At, B0); PG8_MMA(0, 1, At, B1); PG8_BAR; PG8_SCHED;
            PG8_LDA(At, 0, 1); PG8_STAGE(PG8_SB(0, 0), b2, voffB); PG8_STAGE(PG8_SB(0, 1), b2 + hstep, voffB); PG8_STAGE(PG8_SA(0, 0), a2, voffA);
            PG8_WAIT_V_UNLESS(8, skipw); PG8_WAIT_L(0); PG8_BAR; PG8_MMA(1, 0, At, B0); PG8_MMA(1, 1, At, B1); PG8_BAR; PG8_SCHED;
            PG8_LDB(B0, 1, 0); PG8_LDB(B1, 1, 1); PG8_SCHED; PG8_LDA(At, 1, 0); PG8_STAGE(PG8_SA(0, 1), a2 + hstepA, voffA);
            PG8_WAIT_V(8); PG8_WAIT_L(0); PG8_BAR; PG8_MMA(0, 0, At, B0); PG8_MMA(0, 1, At, B1); PG8_BAR; PG8_SCHED;
            PG8_LDA(At, 1, 1); PG8_STAGE(PG8_SB(1, 0), b3, voffB); PG8_STAGE(PG8_SB(1, 1), b3 + hstep, voffB); PG8_STAGE(PG8_SA(1, 0), a3, voffA);
            PG8_WAIT_V(8); PG8_WAIT_L(0); PG8_BAR; PG8_MMA(1, 0, At, B0); PG8_MMA(1, 1, At, B1); PG8_BAR; PG8_SCHED;
            } else {
            PG8_LDB(B0, 0, 0); PG8_SCHED; PG8_LDA(At, 0, 0); PG8_STAGE(PG8_SA(1, 1), a1 + hstepA, voffA);
            PG8_WAIT_L(8); PG8_BAR; PG8_WAIT_L(0); PG8_MMA(0, 0, At, B0); PG8_BAR; PG8_SCHED;
            PG8_LDB(B1, 0, 1); PG8_STAGE(PG8_SB(0, 0), b2, voffB);
            PG8_BAR; PG8_WAIT_L(0); PG8_MMA(0, 1, At, B1); PG8_BAR;
            PG8_LDA(At, 0, 1); PG8_STAGE(PG8_SA(0, 0), a2, voffA);
            PG8_BAR; PG8_WAIT_L(0); PG8_MMA(1, 0, At, B0); PG8_BAR; PG8_SCHED;
            PG8_STAGE(PG8_SB(0, 1), b2 + hstep, voffB);
            PG8_WAIT_V(6); PG8_BAR; PG8_MMA(1, 1, At, B1); PG8_BAR;
            PG8_LDB(B0, 1, 0); PG8_SCHED; PG8_LDA(At, 1, 0); PG8_STAGE(PG8_SA(0, 1), a2 + hstepA, voffA);
            PG8_WAIT_L(8); PG8_BAR; PG8_WAIT_L(0); PG8_MMA(0, 0, At, B0); PG8_BAR; PG8_SCHED;
            PG8_LDB(B1, 1, 1); PG8_STAGE(PG8_SB(1, 0), b3, voffB);
            PG8_BAR; PG8_WAIT_L(0); PG8_MMA(0, 1, At, B1); PG8_BAR;
            PG8_LDA(At, 1, 1); PG8_STAGE(PG8_SA(1, 0), a3, voffA);
            PG8_BAR; PG8_WAIT_L(0); PG8_MMA(1, 0, At, B0); PG8_BAR; PG8_SCHED;
            PG8_STAGE(PG8_SB(1, 1), b3 + hstep, voffB);
            PG8_WAIT_V(6); PG8_BAR; PG8_MMA(1, 1, At, B1); PG8_BAR;
            }
        }
        if constexpr (ALIGN_EPI) { if (wr == 0) PG8_BAR; }
        if constexpr (Epi::SPLIT) PG8_WAIT_V(0);
        if constexpr (!Epi::AFTER_DRAIN) { if constexpr (Epi::FUSEDN) { static_assert(ALIGN_EPI, "the fused-norm epilogue has workgroup barriers: both halves must reach it together"); E.fusedn(acc, cur, wr, wc, fr, fq, lds, wid, lane); } else E(acc, cur, wr, wc, fr, fq); S.done(cur); }
        if (!has_next) break;
#pragma unroll
        for (int a = 0; a < 2; ++a)
#pragma unroll
            for (int b = 0; b < 2; ++b)
#pragma unroll
                for (int m = 0; m < 4; ++m)
#pragma unroll
                    for (int n = 0; n < 2; ++n) acc[a][b][m][n] = (f32x4){0.f, 0.f, 0.f, 0.f};
        cur = nxt; cA = nA; cB = nB; ++ui;
        if constexpr (ALIGN_EPI) { if (wr == 1) PG8_BAR; }
    }
    PG8_WAIT_V(0);
    if constexpr (!ALIGN_EPI) { if (wr == 0) PG8_BAR; }
    PG8_BAR;
    if constexpr (Epi::AFTER_DRAIN) { E.fused(acc, cur, wr, wc, fr, fq, lds, wid, lane); S.done(cur); }
#undef PG8_SA
#undef PG8_SB
#undef PG8_STAGE
#undef PG8_LDA
#undef PG8_LDB
#undef PG8_MMA
#undef PG8_WAIT_V
#undef PG8_WAIT_V_UNLESS
#undef PG8_WAIT_L
#undef PG8_BAR
#undef PG8_SCHED
}
}
#include <hip/hip_bf16.h>
#include <cmath>
namespace attn_body {
using bf16=__hip_bfloat16;
using bf16x8=__attribute__((ext_vector_type(8)))short;
using s16x4=__attribute__((ext_vector_type(4)))short;
using f32x16=__attribute__((ext_vector_type(16)))float;
using u32x4=__attribute__((ext_vector_type(4)))unsigned;
constexpr int BATCH=32,NHEAD=8,SEQ=2048,D=64,DM=512,OPITCH=1024;
constexpr int NW=8,QBLK=32,QB=QBLK*NW,KVBLK=64,NQB=SEQ/QB;
constexpr int ATTN_PITCH=DM, ATTN_UNIT_ROWS=QB;
__device__ __forceinline__ int crow(int r,int hi){return (r&3)+8*(r>>2)+4*hi;}
#define SBAR() __builtin_amdgcn_sched_barrier(0)
__device__ __forceinline__ void cmask(f32x16&p0,f32x16&p1,int jb,int qrel,int hi){
  const float NEG=-INFINITY; int kb=64*jb+4*hi;
  #pragma unroll
  for(int r=0;r<16;++r){int kv=kb+(r&3)+8*(r>>2); if(kv>qrel)p0[r]=NEG; if(kv+32>qrel)p1[r]=NEG;}
}

constexpr int NSLOT=3, SLOTB=8192;
constexpr int LDS_K=0, LDS_V=NSLOT*SLOTB, LDS_WS=2*NSLOT*SLOTB, LDS_OST=LDS_WS+NW*64*4, LDS_KA=LDS_OST+NW*4096,LDS_BYTES=LDS_KA+SEQ*16;
constexpr float C2=0.125f*1.4426950408889634f;
__device__ __forceinline__ void glds16(const void*gsrc,unsigned lds_dst){unsigned keep;
  asm volatile("s_mov_b32 %0, m0\n\ts_mov_b32 m0, %2\n\ts_nop 0\n\tglobal_load_lds_dwordx4 %1, off\n\ts_mov_b32 m0, %0":"=&s"(keep):"v"(gsrc),"s"(lds_dst):"memory");}
__device__ __forceinline__ float max3f(float a,float b,float c){float r;asm("v_max3_f32 %0, %1, %2, %3":"=v"(r):"v"(a),"v"(b),"v"(c));return r;}
__device__ __forceinline__ float max2f(float a,float b){float r;asm("v_max_f32_e32 %0, %1, %2":"=v"(r):"v"(a),"v"(b));return r;}
__device__ __forceinline__ float fadd_s(float a,float b){float r;asm("v_add_f32_e32 %0, %1, %2":"=v"(r):"v"(a),"v"(b));return r;}
__device__ __forceinline__ float fsub_s(float a,float b){float r;asm("v_sub_f32_e32 %0, %1, %2":"=v"(r):"v"(a),"v"(b));return r;}
typedef float f32x2_t __attribute__((ext_vector_type(2))); typedef __bf16 bf16x2_t __attribute__((ext_vector_type(2)));
__device__ __forceinline__ unsigned cvtpk_s(float lo,float hi){f32x2_t v={lo,hi};bf16x2_t b=__builtin_convertvector(v,bf16x2_t);return __builtin_bit_cast(unsigned,b);}
#define WAIT_BAR(N) asm volatile("s_waitcnt vmcnt(" #N ") lgkmcnt(0)\n\ts_barrier":::"memory")

__device__ __forceinline__ void qkt(f32x16&p0,f32x16&p1,const char*Kslot,const bf16x8*qr,const f32x16&negm,int r32,int hi,const bf16x8&ka0,const bf16x8&ka1,const bf16x8&qa){
  const char*kb=Kslot+hi*1024+r32*16;
  #pragma unroll
  for(int d0=0;d0<4;++d0){
    const bf16x8 b0=*reinterpret_cast<const bf16x8*>(kb+d0*2048);
    const bf16x8 b1=*reinterpret_cast<const bf16x8*>(kb+d0*2048+512);
    if(d0==0){p0=__builtin_amdgcn_mfma_f32_32x32x16_bf16(b0,qr[0],negm,0,0,0);p1=__builtin_amdgcn_mfma_f32_32x32x16_bf16(b1,qr[0],negm,0,0,0);}
    else{p0=__builtin_amdgcn_mfma_f32_32x32x16_bf16(b0,qr[d0],p0,0,0,0);p1=__builtin_amdgcn_mfma_f32_32x32x16_bf16(b1,qr[d0],p1,0,0,0);}}
  p0=__builtin_amdgcn_mfma_f32_32x32x16_bf16(ka0,qa,p0,0,0,0);p1=__builtin_amdgcn_mfma_f32_32x32x16_bf16(ka1,qa,p1,0,0,0);
}
typedef __attribute__((address_space(3))) const char* lds_cptr;
typedef short v4i16_t __attribute__((ext_vector_type(4)));
__device__ __forceinline__ void kload8(bf16x8*kf,lds_cptr kp){
  kf[0]=*(const __attribute__((address_space(3))) bf16x8*)(kp);      kf[1]=*(const __attribute__((address_space(3))) bf16x8*)(kp+512);
  kf[2]=*(const __attribute__((address_space(3))) bf16x8*)(kp+2048); kf[3]=*(const __attribute__((address_space(3))) bf16x8*)(kp+2560);
  kf[4]=*(const __attribute__((address_space(3))) bf16x8*)(kp+4096); kf[5]=*(const __attribute__((address_space(3))) bf16x8*)(kp+4608);
  kf[6]=*(const __attribute__((address_space(3))) bf16x8*)(kp+6144); kf[7]=*(const __attribute__((address_space(3))) bf16x8*)(kp+6656);
}
__device__ __forceinline__ void kload2(bf16x8*kf,lds_cptr kp,int j){ kf[2*j]=*(const __attribute__((address_space(3))) bf16x8*)(kp+j*2048); kf[2*j+1]=*(const __attribute__((address_space(3))) bf16x8*)(kp+j*2048+512); }
__device__ __forceinline__ s16x4 vtr(lds_cptr p){ return __builtin_bit_cast(s16x4,__builtin_amdgcn_ds_read_tr16_b64_v4i16((__attribute__((address_space(3))) v4i16_t*)p)); }
__device__ __forceinline__ float rowmax(const f32x16&p0,const f32x16&p1){
  float a=max3f(p0[0],p0[1],p1[0]),b=max3f(p0[2],p0[3],p1[1]);a=max3f(a,p1[2],p1[3]);
  #pragma unroll
  for(int r=4;r<16;r+=4){a=max3f(a,p0[r],p0[r+1]);b=max3f(b,p0[r+2],p0[r+3]);a=max3f(a,p1[r],p1[r+1]);b=max3f(b,p1[r+2],p1[r+3]);}
  const float m=max2f(a,b);
  auto rr=__builtin_amdgcn_permlane32_swap(__float_as_uint(m),__float_as_uint(m),false,false);
  return max2f(__uint_as_float(rr[0]),__uint_as_float(rr[1]));
}
__device__ __forceinline__ void pv(f32x16*o,int vb,bf16x8 pa0,bf16x8 pa1,bf16x8 pa2,bf16x8 pa3){
  #pragma unroll
  for(int d0=0;d0<2;++d0){s16x4 lo[4],hi[4];
    #pragma unroll
    for(int ks=0;ks<4;++ks){
      asm volatile("ds_read_b64_tr_b16 %0,%1 offset:%c2":"=&v"(lo[ks]):"v"(vb),"i"(d0*4096+ks*1024):"memory");
      asm volatile("ds_read_b64_tr_b16 %0,%1 offset:%c2":"=&v"(hi[ks]):"v"(vb),"i"(d0*4096+ks*1024+512):"memory");}
    asm volatile("s_waitcnt lgkmcnt(0)":::"memory");SBAR();
    #define PK(k) (bf16x8){lo[k][0],lo[k][1],lo[k][2],lo[k][3],hi[k][0],hi[k][1],hi[k][2],hi[k][3]}
    o[d0]=__builtin_amdgcn_mfma_f32_32x32x16_bf16(pa0,PK(0),o[d0],0,0,0);
    o[d0]=__builtin_amdgcn_mfma_f32_32x32x16_bf16(pa1,PK(1),o[d0],0,0,0);
    o[d0]=__builtin_amdgcn_mfma_f32_32x32x16_bf16(pa2,PK(2),o[d0],0,0,0);
    o[d0]=__builtin_amdgcn_mfma_f32_32x32x16_bf16(pa3,PK(3),o[d0],0,0,0);
    #undef PK
  }
}

#ifndef ATTN_STORE16
#define ATTN_STORE16(p,v) (*(u32x4*)(p)=(v))
#endif
template<int THRL,bool COPYF> __device__ __forceinline__ void attn_unit(int b,int h,int qb,const bf16*Q,const bf16*__restrict__ K,const bf16*__restrict__ V,bf16*O,const float*__restrict__ Fg,float*__restrict__ ssq,char*shm){
  int tid_=threadIdx.x; asm volatile("":"+v"(tid_)); const int tid=tid_,lane=tid&63,r32=lane&31,hi=lane>>5; const int wid=__builtin_amdgcn_readfirstlane(tid>>6);
  const long rowbase=(long)b*SEQ; const int q0=qb*QB;
  const bf16*Qw=Q+(rowbase+q0+wid*QBLK)*DM+h*D;
  const bf16*Kh=K+rowbase*DM+h*D,*Vh=V+rowbase*DM+h*D;
  const lds_cptr shm3=(lds_cptr)shm;
  const unsigned lds0=(unsigned)(uintptr_t)shm;
  float*wsf=(float*)(shm+LDS_WS)+wid*64;
  const bf16*ksrc=Kh+(long)lane*DM+wid*8;
  const bf16*vsrc=Vh+(long)(16*(wid&3)+(lane>>2))*DM+(wid>>2)*32+(lane&3)*8;
  const unsigned kdst=lds0+LDS_K+wid*1024, vdst=lds0+LDS_V+wid*1024;
  #define DMA_K(t,slot) glds16(ksrc+(long)(t)*KVBLK*DM,(unsigned)__builtin_amdgcn_readfirstlane(kdst+(slot)))
  #define DMA_V(t,slot) glds16(vsrc+(long)(t)*KVBLK*DM,(unsigned)__builtin_amdgcn_readfirstlane(vdst+(slot)))
  const int vb0=(int)(lds0+LDS_V)+((lane>>4)&1)*32+(lane&3)*8+(4*hi+((lane&15)>>2))*64;
  const char*Kbase=shm+LDS_K; bf16x8 kf[8];
  const lds_cptr kp0=shm3+LDS_K+hi*1024+r32*16; const lds_cptr vp0=shm3+LDS_V+((lane>>4)&1)*32+(lane&3)*8+(4*hi+((lane&15)>>2))*64;
  const int NT=(q0+QB)/KVBLK;
  typedef float f32x4_t __attribute__((ext_vector_type(4))); typedef __attribute__((address_space(3))) u32x4 lds_u4; typedef __attribute__((address_space(3))) const bf16x8 lds_cfrag;
  f32x4_t fv_=f32x4_t{}; const bool docp_=COPYF&&(tid*4<q0+QB); if(docp_)fv_=*reinterpret_cast<const f32x4_t*>(Fg+tid*4);
  const float gq_=Fg[q0+wid*QBLK+r32];
  DMA_K(0,0);DMA_V(0,0);DMA_K(1,SLOTB);
  bf16x8 qr[4];
  #pragma unroll
  for(int d0=0;d0<4;++d0)qr[d0]=*reinterpret_cast<const bf16x8*>(&Qw[(long)r32*DM+d0*16+hi*8]);
  float mhat=0.f,l_reg=0.f;f32x16 o[2];o[0]=f32x16{};o[1]=f32x16{};f32x16 negm=f32x16{};asm volatile("":"+v"(negm));
  const int qrel=wid*QBLK+r32;
  #define CMASK(P0,P1,t) do{int jb_=(t)-(NT-4); if(jb_>=0)cmask(P0,P1,jb_,qrel,hi);}while(0)
  bool resc=false;
  #define START(P0,P1) do{ const float rm=rowmax(P0,P1); resc=false; \
    { const float dl=rm; mhat=fadd_s(mhat,dl); \
      _Pragma("unroll") for(int r=0;r<16;++r){P0[r]=fsub_s(P0[r],dl);P1[r]=fsub_s(P1[r],dl);} \
      _Pragma("unroll") for(int r=0;r<16;++r)negm[r]=-mhat; asm volatile("":"+v"(negm)); } \
    _Pragma("unroll") for(int r=0;r<16;++r)P0[r]=__builtin_amdgcn_exp2f(P0[r]); }while(0)
  #define RESC() do{ if(resc){ asm volatile("s_waitcnt lgkmcnt(0)":::"memory"); \
      _Pragma("unroll") for(int d_=0;d_<2;++d_) _Pragma("unroll") for(int r=0;r<16;++r)o[d_][r]*=wsf[crow(r,hi)]; } }while(0)
  f32x16 pA0,pA1,pB0,pB1;
  int sl_prev=0,sl_cur=0,sl_next=SLOTB;
  #define ROT() do{sl_prev=sl_cur;sl_cur=sl_next;sl_next=(sl_next==(NSLOT-1)*SLOTB)?0:sl_next+SLOTB;}while(0)
  DMA_K(2,2*SLOTB);
  #define SPLIT3(x,H,M,L) do{ const unsigned h_=cvtpk_s((x),0.f)&0xffffu; const float r1_=(x)-__uint_as_float(h_<<16); const unsigned m_=cvtpk_s(r1_,0.f)&0xffffu; const float r2_=r1_-__uint_as_float(m_<<16); H=h_; M=m_; L=cvtpk_s(r2_,0.f)&0xffffu; }while(0)
  if(docp_){ _Pragma("unroll") for(int e_=0;e_<4;++e_){ unsigned fh_,fm_,fl_; const float f_=-fv_[e_]; SPLIT3(f_,fh_,fm_,fl_);
      *(lds_u4*)(shm3+LDS_KA+(tid*4+e_)*16)=(u32x4){fh_|(fm_<<16),fl_|0x3f800000u,0x3f803f80u,0u}; } }
  bf16x8 qa; { unsigned gh_,gm_,gl_; SPLIT3(gq_,gh_,gm_,gl_); const u32x4 w_=hi?(u32x4){0u,0u,0u,0u}:(u32x4){0x3f803f80u,0x3f80u|(gh_<<16),gm_|(gl_<<16),0u}; qa=__builtin_bit_cast(bf16x8,w_); }
  #undef SPLIT3
  const lds_cptr kap=shm3+LDS_KA+r32*16;
  WAIT_BAR(3);
  { const bf16x8 ka0s_=*(lds_cfrag*)(kap), ka1s_=*(lds_cfrag*)(kap+512); qkt(pA0,pA1,Kbase,qr,negm,r32,hi,ka0s_,ka1s_,qa); }asm volatile("s_nop 15\n\ts_nop 7":"+v"(pA0),"+v"(pA1));CMASK(pA0,pA1,0);
  START(pA0,pA1);
  _Pragma("unroll") for(int r=0;r<16;++r)pA1[r]=__builtin_amdgcn_exp2f(pA1[r]);
  WAIT_BAR(0);
  DMA_K(3,0);DMA_V(1,SLOTB);
  ROT();
  kload8(kf,kp0+sl_cur);
  WAIT_BAR(2);
  s16x4 vlo[8],vhi[8]; u32x4 pw0,pw1,pw2,pw3;
  #define PKW(P,B) cvtpk_s(P[B],P[B+1])
  #define PAF(k) __builtin_bit_cast(bf16x8,pw##k)
  #define VFR(i) (bf16x8){vlo[i][0],vlo[i][1],vlo[i][2],vlo[i][3],vhi[i][0],vhi[i][1],vhi[i][2],vhi[i][3]}
  #define PIN(x) asm volatile("":"+v"(x))
  #define MX3(a,b,c) __builtin_fmaxf(__builtin_fmaxf((a),(b)),(c))
  #define GAPA(MF,A0,A1,A2,A3,W0,W1,PW) do{ MF; sacc+=A0; sacc+=A1; sacc+=A2; sacc+=A3; PIN(sacc); W0; W1; PIN(PW); SBAR(); }while(0)
  #define EX(v) __builtin_amdgcn_exp2f(v)
  #define GAPB(MF,X,B) do{ MF; X[B]=EX(X[B]); X[B+1]=EX(X[B+1]); X[B+2]=EX(X[B+2]); X[B+3]=EX(X[B+3]); PIN(X); SBAR(); }while(0)
  #define VRD(i) do{ vlo[i]=vtr(vp_+(((i)>>2)*4096+((i)&3)*1024)); vhi[i]=vtr(vp_+(((i)>>2)*4096+((i)&3)*1024+512)); }while(0)
  #define KRD(G,j) do{ if(G){ kload2(kf,kp0+sl_next,j); SBAR(); } }while(0)
  #define STEP(C0,C1,P0,P1,t,GK,GV,GL) do{ SBAR(); \
    const lds_cptr vp_=vp0+sl_prev; const bf16x8 ka0_=*(lds_cfrag*)(kap+(t)*1024), ka1_=*(lds_cfrag*)(kap+(t)*1024+512); \
    VRD(0); SBAR(); float sacc=(P0[0]+P0[1]); \
    GAPA(C0=__builtin_amdgcn_mfma_f32_32x32x16_bf16(kf[0],qr[0],negm,0,0,0), P0[2],P0[3],P0[4],P0[5],     pw0[0]=PKW(P0,0), pw0[1]=PKW(P0,2), pw0); \
    VRD(4); SBAR(); GAPA(C1=__builtin_amdgcn_mfma_f32_32x32x16_bf16(kf[1],qr[0],negm,0,0,0), P0[6],P0[7],P0[8],P0[9],     pw0[2]=PKW(P0,4), pw0[3]=PKW(P0,6), pw0); \
    VRD(1); SBAR(); GAPA(C0=__builtin_amdgcn_mfma_f32_32x32x16_bf16(kf[2],qr[1],C0,0,0,0),   P0[10],P0[11],P0[12],P0[13], pw1[0]=PKW(P0,8), pw1[1]=PKW(P0,10), pw1); \
    VRD(5); SBAR(); GAPA(C1=__builtin_amdgcn_mfma_f32_32x32x16_bf16(kf[3],qr[1],C1,0,0,0),   P0[14],P0[15],P1[0],P1[1],   pw1[2]=PKW(P0,12),pw1[3]=PKW(P0,14), pw1); \
    VRD(2); SBAR(); GAPA(C0=__builtin_amdgcn_mfma_f32_32x32x16_bf16(kf[4],qr[2],C0,0,0,0),   P1[2],P1[3],P1[4],P1[5],     pw2[0]=PKW(P1,0), pw2[1]=PKW(P1,2), pw2); \
    VRD(6); SBAR(); GAPA(C1=__builtin_amdgcn_mfma_f32_32x32x16_bf16(kf[5],qr[2],C1,0,0,0),   P1[6],P1[7],P1[8],P1[9],     pw2[2]=PKW(P1,4), pw2[3]=PKW(P1,6), pw2); \
    VRD(3); SBAR(); GAPA(C0=__builtin_amdgcn_mfma_f32_32x32x16_bf16(kf[6],qr[3],C0,0,0,0),   P1[10],P1[11],P1[12],P1[13], pw3[0]=PKW(P1,8), pw3[1]=PKW(P1,10), pw3); \
    VRD(7); SBAR(); GAPA(C1=__builtin_amdgcn_mfma_f32_32x32x16_bf16(kf[7],qr[3],C1,0,0,0),   P1[14],P1[15],0.f,0.f,       pw3[2]=PKW(P1,12),pw3[3]=PKW(P1,14), pw3); \
    C0=__builtin_amdgcn_mfma_f32_32x32x16_bf16(ka0_,qa,C0,0,0,0); C1=__builtin_amdgcn_mfma_f32_32x32x16_bf16(ka1_,qa,C1,0,0,0); SBAR(); \
    l_reg+=sacc; \
    if(GK){DMA_K((t)+3,sl_cur);} if(GV){DMA_V((t)+1,sl_next);} \
    CMASK(C0,C1,t); \
    { float a=MX3(C0[0],C0[1],C1[0]),b=MX3(C0[2],C0[3],C1[1]); a=MX3(a,C1[2],C1[3]); \
      _Pragma("unroll") for(int r=4;r<16;r+=4){a=MX3(a,C0[r],C0[r+1]);b=MX3(b,C0[r+2],C0[r+3]);a=MX3(a,C1[r],C1[r+1]);b=MX3(b,C1[r+2],C1[r+3]);} \
      float rm=__builtin_fmaxf(a,b); { auto rr=__builtin_amdgcn_permlane32_swap(__float_as_uint(rm),__float_as_uint(rm),false,false); rm=__builtin_fmaxf(__uint_as_float(rr[0]),__uint_as_float(rr[1])); } \
      resc=false; \
      if(__builtin_expect(__any(rm>(float)THRL),0)){ const float dl=__builtin_fmaxf(rm,0.f); mhat+=dl; \
        _Pragma("unroll") for(int r=0;r<16;++r){C0[r]-=dl;C1[r]-=dl;} \
        _Pragma("unroll") for(int r=0;r<16;++r)negm[r]=-mhat; asm volatile("":"+v"(negm)); \
        const float f=__builtin_amdgcn_exp2f(-dl); l_reg*=f; if(hi==0)wsf[r32]=f; resc=true; } } \
    SBAR(); \
    GAPB(o[0]=__builtin_amdgcn_mfma_f32_32x32x16_bf16(PAF(0),VFR(0),o[0],0,0,0), C0,0); \
    GAPB(o[1]=__builtin_amdgcn_mfma_f32_32x32x16_bf16(PAF(0),VFR(4),o[1],0,0,0), C0,4); \
    KRD(GL,0); GAPB(o[0]=__builtin_amdgcn_mfma_f32_32x32x16_bf16(PAF(1),VFR(1),o[0],0,0,0), C0,8); \
    KRD(GL,1); GAPB(o[1]=__builtin_amdgcn_mfma_f32_32x32x16_bf16(PAF(1),VFR(5),o[1],0,0,0), C0,12); \
    KRD(GL,2); GAPB(o[0]=__builtin_amdgcn_mfma_f32_32x32x16_bf16(PAF(2),VFR(2),o[0],0,0,0), C1,0); \
    KRD(GL,3); GAPB(o[1]=__builtin_amdgcn_mfma_f32_32x32x16_bf16(PAF(2),VFR(6),o[1],0,0,0), C1,4); \
    GAPB(o[0]=__builtin_amdgcn_mfma_f32_32x32x16_bf16(PAF(3),VFR(3),o[0],0,0,0), C1,8); \
    GAPB(o[1]=__builtin_amdgcn_mfma_f32_32x32x16_bf16(PAF(3),VFR(7),o[1],0,0,0), C1,12); \
    }while(0)
  int t=1;
  #undef CMASK
  #define CMASK(P0,P1,t) do{}while(0)
  for(;t+5<NT;t+=2){
    STEP(pB0,pB1,pA0,pA1,t,true,true,true);     WAIT_BAR(2); RESC(); ROT();
    STEP(pA0,pA1,pB0,pB1,t+1,true,true,true);   WAIT_BAR(2); RESC(); ROT();
  }
  #undef CMASK
  #define CMASK(P0,P1,t) do{int jb_=(t)-(NT-4); if(jb_>=0)cmask(P0,P1,jb_,qrel,hi);}while(0)
  #define ENDW(tt) do{ if((tt)+3<NT){WAIT_BAR(2);} else if((tt)+2<NT){WAIT_BAR(1);} else {WAIT_BAR(0);} }while(0)
  for(;t+1<NT;t+=2){
    STEP(pB0,pB1,pA0,pA1,t,(t+3<NT),(t+1<NT),(t+1<NT));       ENDW(t);   RESC(); ROT();
    STEP(pA0,pA1,pB0,pB1,t+1,(t+4<NT),(t+2<NT),(t+2<NT));     ENDW(t+1); RESC(); ROT();
  }
  STEP(pB0,pB1,pA0,pA1,NT-1,false,false,false); RESC();
  { float sacc=pB0[0]+pB0[1]; _Pragma("unroll") for(int r=2;r<16;++r)sacc+=pB0[r]; _Pragma("unroll") for(int r=0;r<16;++r)sacc+=pB1[r]; l_reg+=sacc;
    pw0=(u32x4){PKW(pB0,0),PKW(pB0,2),PKW(pB0,4),PKW(pB0,6)};pw1=(u32x4){PKW(pB0,8),PKW(pB0,10),PKW(pB0,12),PKW(pB0,14)};pw2=(u32x4){PKW(pB1,0),PKW(pB1,2),PKW(pB1,4),PKW(pB1,6)};pw3=(u32x4){PKW(pB1,8),PKW(pB1,10),PKW(pB1,12),PKW(pB1,14)};
    SBAR(); pv(o,vb0+sl_cur,PAF(0),PAF(1),PAF(2),PAF(3)); }
  #undef PKW
  #undef PAF
  #undef VFR
  #undef PIN
  #undef MX3
  #undef GAPA
  #undef GAPB
  #undef EX
  #undef VRD
  #undef KRD
  #undef STEP
  #undef ENDW
  {auto rr=__builtin_amdgcn_permlane32_swap(__float_as_uint(l_reg),__float_as_uint(l_reg),false,false);l_reg=__uint_as_float(rr[0])+__uint_as_float(rr[1]);}
  if(hi==0)wsf[32+r32]=l_reg;asm volatile("s_waitcnt lgkmcnt(0)":::"memory");
  float rli[16];
  #pragma unroll
  for(int r=0;r<16;++r)rli[r]=__builtin_amdgcn_rcpf(wsf[32+crow(r,hi)]);
  bf16*Ow=O+(rowbase+q0+wid*QBLK)*OPITCH+h*D; float*sq=ssq+(rowbase+q0+wid*QBLK)*NHEAD+h;
  { bf16*stg=(bf16*)(shm+LDS_OST)+wid*2048;
    #pragma unroll
    for(int r=0;r<16;++r){const int orow=crow(r,hi);
      #pragma unroll
      for(int d0=0;d0<2;++d0)stg[orow*64+d0*32+r32]=__float2bfloat16(o[d0][r]*rli[r]);}
    asm volatile("s_waitcnt lgkmcnt(0)":::"memory");
    #pragma unroll
    for(int i=0;i<4;++i){const int row=i*8+(lane>>3),ch=lane&7; const u32x4 v=*(const u32x4*)(stg+row*64+ch*8); ATTN_STORE16(Ow+(long)row*OPITCH+ch*8,v);
      float s2=0.f; _Pragma("unroll") for(int e=0;e<4;++e){ const float lo_=__uint_as_float(v[e]<<16), hi_=__uint_as_float(v[e]&0xffff0000u); s2+=lo_*lo_+hi_*hi_; }
      s2+=__shfl_xor(s2,1); s2+=__shfl_xor(s2,2); s2+=__shfl_xor(s2,4); if(ch==0)sq[(long)row*NHEAD]=s2; } }
  asm volatile("s_waitcnt lgkmcnt(0)\n\ts_barrier":::"memory");
  #undef DMA_K
  #undef DMA_V
  #undef CMASK
  #undef START
  #undef RESC
  #undef ROT
}
constexpr int ATTN_LDS_BYTES=LDS_BYTES;
#undef SBAR
#undef WAIT_BAR
}
namespace hg {
#define HLAS __attribute__((address_space(3)))
typedef short bf16x8 __attribute__((ext_vector_type(8)));
typedef short v4i16_t __attribute__((ext_vector_type(4)));
typedef float f32x16 __attribute__((ext_vector_type(16)));
typedef float f32x4 __attribute__((ext_vector_type(4)));
typedef unsigned u32x4 __attribute__((ext_vector_type(4)));
typedef float f32x2_t __attribute__((ext_vector_type(2))); typedef __bf16 bf16x2_t __attribute__((ext_vector_type(2)));
typedef unsigned short bf16_t;
__device__ __forceinline__ unsigned cvtpk(float lo, float hi) { f32x2_t v = {lo, hi}; bf16x2_t b = __builtin_convertvector(v, bf16x2_t); return __builtin_bit_cast(unsigned, b); }
__device__ __forceinline__ unsigned off_b(unsigned row, unsigned ch) { return 272u * row + 16u * ch; }
__device__ __forceinline__ int crow(int reg, int h) { return (reg & 3) + 8 * (reg >> 2) + 4 * h; }
__device__ __forceinline__ bf16x8 pack8(const f32x16& x, int s) {
    u32x4 p; p.x = cvtpk(x[8 * s], x[8 * s + 1]); p.y = cvtpk(x[8 * s + 2], x[8 * s + 3]); p.z = cvtpk(x[8 * s + 4], x[8 * s + 5]); p.w = cvtpk(x[8 * s + 6], x[8 * s + 7]);
    return __builtin_bit_cast(bf16x8, p);
}
__device__ __forceinline__ v4i16_t trd(HLAS const unsigned char* p) { return __builtin_amdgcn_ds_read_tr16_b64_v4i16((HLAS v4i16_t*)p); }
__device__ __forceinline__ void glds16(const void* gsrc, unsigned lds_dst) { unsigned keep;
    asm volatile("s_mov_b32 %0, m0\n\ts_mov_b32 m0, %2\n\ts_nop 0\n\tglobal_load_lds_dwordx4 %1, off\n\ts_mov_b32 m0, %0" : "=&s"(keep) : "v"(gsrc), "s"(lds_dst) : "memory"); }
__device__ __forceinline__ unsigned off_v(unsigned row, unsigned ch) { return 256u * row + 16u * ch; }
#define HMFMA(a, b, c) __builtin_amdgcn_mfma_f32_32x32x16_bf16((a), (b), (c), 0, 0, 0)
#define HG_BAR() do { asm volatile("s_waitcnt lgkmcnt(0)" ::: "memory"); __builtin_amdgcn_s_barrier(); asm volatile("" ::: "memory"); } while (0)
constexpr int IMG_ONE = 64 * 272, IMG_QT = 0, IMG_QP = IMG_ONE, IMG_KH = 2 * IMG_ONE, IMG_VV = 3 * IMG_ONE, IMG_BYTES = 4 * IMG_ONE, AUX_BYTES = 2560, OB_PITCH = 132;
constexpr int NCH = 32, CH = 64, PITCH = 512, OPITCH = 1024;

__device__ __forceinline__ void hgrn_unit(int unit, const bf16_t* QF, const bf16_t* KK, const bf16_t* VI, const bf16_t* GH, bf16_t* OC, HLAS unsigned char* lds, HLAS unsigned char* aux0) {
    int tid_ = threadIdx.x; asm volatile("" : "+v"(tid_));
    const int tid = tid_, lane = tid & 63, wid = __builtin_amdgcn_readfirstlane(tid >> 6), role = wid >> 2, gw = wid & 3, gt = tid & 255;
    const int bh = unit, b = bh >> 2, h = bh & 3, r32 = lane & 31, hh = lane >> 5;
    const size_t rowbase = (size_t)b * 2048; const int cb = h * 128;
    const int blk = (lane >> 4) & 1, tq = (lane & 15) >> 2, tp = lane & 3;
#define HG_DMA_V(c) do { const bf16_t* vs_ = VI + (rowbase + (size_t)(c) * CH + 16 * gw + (lane >> 4)) * PITCH + cb + 8 * (lane & 15); const unsigned vdst0 = (unsigned)(size_t)(img + IMG_VV) + (unsigned)(16 * gw) * 256u; \
        _Pragma("unroll") for (int j = 0; j < 4; ++j) glds16(vs_ + (size_t)(4 * j) * PITCH, (unsigned)__builtin_amdgcn_readfirstlane(vdst0 + 1024u * j)); } while (0)
#define HG_LOAD_RAW(KD, QD, c) do { const size_t r0_ = rowbase + (size_t)(c) * CH; \
        _Pragma("unroll") for (int i = 0; i < 16; ++i) { const size_t o_ = (r0_ + 16 * gw + i) * PITCH + cb + 2 * lane; KD[i] = *(const unsigned*)(KK + o_); QD[i] = *(const unsigned*)(QF + o_); } \
        } while (0)
    if (role == 0) {
        unsigned kk2[16], qf2[16], kkn[16], qfn[16];
#pragma unroll
        for (int i = 0; i < 16; ++i) { kkn[i] = 0u; qfn[i] = 0u; }
        HG_LOAD_RAW(kk2, qf2, 0);
        for (int s = 0; s <= NCH; ++s) {
            HLAS unsigned char* img = lds + (s & 1) * IMG_BYTES;
            HLAS float* segtot = (HLAS float*)(aux0 + (s & 1) * AUX_BYTES); HLAS float* dec = segtot + 512;
            float bl0[16], bl1[16]; float a0 = 0.f, a1 = 0.f;
            if (s < NCH) {
                HG_DMA_V(s);
                if (s + 1 < NCH) HG_LOAD_RAW(kkn, qfn, s + 1);
        a0 = 0.f; a1 = 0.f;
#pragma unroll
        for (int i = 0; i < 16; ++i) { const float k0 = __uint_as_float(kk2[i] << 16), k1 = __uint_as_float(kk2[i] & 0xffff0000u);
            a0 += __builtin_amdgcn_logf(fmaxf(1.0f - k0, 1e-30f)); a1 += __builtin_amdgcn_logf(fmaxf(1.0f - k1, 1e-30f)); bl0[i] = a0; bl1[i] = a1; }
        *(HLAS f32x2_t*)(segtot + gw * 128 + 2 * lane) = (f32x2_t){a0, a1};
            }
            HG_BAR();
            if (s < NCH) {
        float p0 = 0.f, p1 = 0.f, t0 = 0.f, t1 = 0.f;
#pragma unroll
        for (int w = 0; w < 4; ++w) { const f32x2_t s = *(HLAS const f32x2_t*)(segtot + w * 128 + 2 * lane); if (w < gw) { p0 += s.x; p1 += s.y; } t0 += s.x; t1 += s.y; }
        const float ei0 = __builtin_amdgcn_exp2f(fminf(-t0, 115.f)), ei1 = __builtin_amdgcn_exp2f(fminf(-t1, 115.f));
        if (gw == 0) *(HLAS f32x2_t*)(dec + 2 * lane) = (f32x2_t){__builtin_amdgcn_exp2f(t0), __builtin_amdgcn_exp2f(t1)};
        {
            const int k = 2 * lane, k16 = k & 15, ng = (((k16 >> 2) & 1) << 1) | (k16 >> 3), pos = (k & ~15) + (ng << 2) + (k16 & 3);
            const unsigned chn = (unsigned)(k >> 3), bn = (unsigned)((k & 7) * 2), chp = (unsigned)(pos >> 3), bp = (unsigned)((pos & 7) * 2);
#pragma unroll
            for (int i = 0; i < 16; ++i) { const unsigned row = 16 * gw + i;
                const float k0 = __uint_as_float(kk2[i] << 16), k1 = __uint_as_float(kk2[i] & 0xffff0000u), q0 = __uint_as_float(qf2[i] << 16), q1 = __uint_as_float(qf2[i] & 0xffff0000u);
                const float e0 = __builtin_amdgcn_exp2f(p0 + bl0[i]), e1 = __builtin_amdgcn_exp2f(p1 + bl1[i]);
                const float l0 = fminf(fmaxf(e0 * ei0, 1e-30f), 1e30f), l1 = fminf(fmaxf(e1 * ei1, 1e-30f), 1e30f);
                *(HLAS unsigned*)(img + IMG_QT + off_b(row, chp) + bp) = cvtpk(q0 * e0, q1 * e1);
                *(HLAS unsigned*)(img + IMG_QP + off_b(row, chn) + bn) = cvtpk(q0 * l0, q1 * l1);
                *(HLAS unsigned*)(img + IMG_KH + off_b(row, chn) + bn) = cvtpk(k0 * __builtin_amdgcn_rcpf(l0), k1 * __builtin_amdgcn_rcpf(l1)); }
        }
                asm volatile("s_waitcnt vmcnt(0)" ::: "memory");
#pragma unroll
                for (int i = 0; i < 16; ++i) { kk2[i] = kkn[i]; qf2[i] = qfn[i]; }
            }
            HG_BAR();
        }
    } else {
        f32x16 S[4];
#pragma unroll
        for (int i = 0; i < 4; ++i) S[i] = f32x16{};
        u32x4 g16[4]; f32x16 o[2];
#pragma unroll
        for (int j = 0; j < 4; ++j) g16[j] = (u32x4){0u, 0u, 0u, 0u};
        o[0] = f32x16{}; o[1] = f32x16{};
        for (int s = 0; s <= NCH + 1; ++s) {
            if (s >= 2) { const int c = s - 2; HLAS float* OB = (HLAS float*)(lds + (c & 1) * IMG_BYTES);
        { const int t = gt >> 2, qd = gt & 3; f32x4 ov[8]; float ss = 0.f;
#pragma unroll
          for (int j = 0; j < 8; ++j) { ov[j] = *(HLAS const f32x4*)(OB + t * OB_PITCH + 32 * qd + 4 * j); ss += (ov[j][0] * ov[j][0] + ov[j][1] * ov[j][1]) + (ov[j][2] * ov[j][2] + ov[j][3] * ov[j][3]); }
          ss += __shfl_xor(ss, 1); ss += __shfl_xor(ss, 2);
          const float rs = 1.0f / sqrtf(ss * (1.0f / 128.0f) + 1e-6f);
          bf16_t* op = OC + (rowbase + (size_t)c * CH + t) * OPITCH + 512 + cb + 32 * qd;
#pragma unroll
          for (int j = 0; j < 4; ++j) { u32x4 w;
#pragma unroll
              for (int e = 0; e < 4; ++e) { const float ga = __uint_as_float(g16[j][e] << 16), gb = __uint_as_float(g16[j][e] & 0xffff0000u);
                  const int f = 2 * e; const f32x4 va = ov[2 * j + (f >> 2)];
                  w[e] = cvtpk(va[f & 3] * rs * ga, va[(f & 3) + 1] * rs * gb); }
              *(u32x4*)(op + 8 * j) = w; } }
            }
            if (s > NCH) break;
            HLAS unsigned char* img = lds + ((s - 1) & 1) * IMG_BYTES; HLAS float* dec = (HLAS float*)(aux0 + ((s - 1) & 1) * AUX_BYTES) + 512; HLAS float* OB = (HLAS float*)img;
            if (s >= 1) { const int c = s - 1;
        { const size_t r0 = rowbase + (size_t)c * CH + (gt >> 2);
#pragma unroll
          for (int j = 0; j < 4; ++j) g16[j] = *(const u32x4*)(GH + r0 * PITCH + cb + 32 * (gt & 3) + 8 * j); }
        o[0] = f32x16{}; o[1] = f32x16{};
#pragma unroll
        for (int kb = 0; kb < 4; ++kb) { const bf16x8 sb0 = pack8(S[kb], 0), sb1 = pack8(S[kb], 1);
#pragma unroll
            for (int tb = 0; tb < 2; ++tb) {
                const bf16x8 a0f = *(HLAS const bf16x8*)(img + IMG_QT + off_b(32 * tb + r32, 4 * kb + hh));
                const bf16x8 a1f = *(HLAS const bf16x8*)(img + IMG_QT + off_b(32 * tb + r32, 4 * kb + 2 + hh));
                o[tb] = HMFMA(a0f, sb0, o[tb]); o[tb] = HMFMA(a1f, sb1, o[tb]); }
            __builtin_amdgcn_sched_barrier(0); }
#pragma unroll
        for (int tb = 0; tb < 2; ++tb)
#pragma unroll
            for (int sb = 0; sb <= tb; ++sb) { f32x16 X = f32x16{};
#pragma unroll
                for (int ks = 0; ks < 8; ++ks) { const bf16x8 af = *(HLAS const bf16x8*)(img + IMG_KH + off_b(32 * sb + r32, 2 * ks + hh)), bf = *(HLAS const bf16x8*)(img + IMG_QP + off_b(32 * tb + r32, 2 * ks + hh));
                    X = HMFMA(af, bf, X); }
                if (sb == tb) {
#pragma unroll
                    for (int r = 0; r < 16; ++r) if (crow(r, hh) > r32) X[r] = 0.f; }
#pragma unroll
                for (int ss = 0; ss < 2; ++ss) { const bf16x8 xa = pack8(X, ss);
                    const unsigned rw = 32 * sb + 16 * ss + 4 * hh + tq;
                    const v4i16_t lo = trd(img + IMG_VV + off_v(rw, 4 * gw + 2 * blk + (tp >> 1)) + 8 * (tp & 1)), hi = trd(img + IMG_VV + off_v(rw + 8, 4 * gw + 2 * blk + (tp >> 1)) + 8 * (tp & 1));
                    const bf16x8 vb = (bf16x8){lo[0], lo[1], lo[2], lo[3], hi[0], hi[1], hi[2], hi[3]};
                    o[tb] = HMFMA(xa, vb, o[tb]); }
                __builtin_amdgcn_sched_barrier(0); }
#pragma unroll
        for (int kb = 0; kb < 4; ++kb)
#pragma unroll
            for (int g4 = 0; g4 < 4; ++g4) { const f32x4 d = *(HLAS const f32x4*)(dec + 32 * kb + 8 * g4 + 4 * hh);
#pragma unroll
                for (int e = 0; e < 4; ++e) S[kb][4 * g4 + e] *= d[e]; }
#pragma unroll
        for (int ss = 0; ss < 4; ++ss) { const unsigned rw = 16 * ss + 8 * hh + tq;
            const v4i16_t vlo = trd(img + IMG_VV + off_v(rw, 4 * gw + 2 * blk + (tp >> 1)) + 8 * (tp & 1)), vhi = trd(img + IMG_VV + off_v(rw + 4, 4 * gw + 2 * blk + (tp >> 1)) + 8 * (tp & 1));
            const bf16x8 vb = (bf16x8){vlo[0], vlo[1], vlo[2], vlo[3], vhi[0], vhi[1], vhi[2], vhi[3]};
#pragma unroll
            for (int kb = 0; kb < 4; ++kb) {
                const v4i16_t klo = trd(img + IMG_KH + off_b(rw, 4 * kb + 2 * blk + (tp >> 1)) + 8 * (tp & 1)), khi = trd(img + IMG_KH + off_b(rw + 4, 4 * kb + 2 * blk + (tp >> 1)) + 8 * (tp & 1));
                const bf16x8 ka = (bf16x8){klo[0], klo[1], klo[2], klo[3], khi[0], khi[1], khi[2], khi[3]};
                S[kb] = HMFMA(ka, vb, S[kb]); }
            __builtin_amdgcn_sched_barrier(0); }
            }
            HG_BAR();
            if (s >= 1) {
#pragma unroll
        for (int tb = 0; tb < 2; ++tb)
#pragma unroll
            for (int r = 0; r < 16; ++r) OB[(32 * tb + crow(r, hh)) * OB_PITCH + 32 * gw + r32] = o[tb][r];
            }
            HG_BAR();
        }
    }
    __syncthreads();
#undef HG_LOAD_RAW
#undef HG_DMA_V
}
#undef HMFMA
#undef HG_BAR
}
#define GAS __attribute__((address_space(1)))
#define LAS __attribute__((address_space(3)))
typedef unsigned short bf16;
typedef unsigned v4u __attribute__((ext_vector_type(4)));
typedef float f32x4 __attribute__((ext_vector_type(4)));
constexpr int T_ = 65536, D_ = 1024, FF_ = 2816, SEQ_ = 2048, NB_ = 32, NMOD_ = 9216, NMIX_ = 3584;
constexpr size_t MiB = 1u << 20;
constexpr size_t WS_CTL = 0, WS_MOD = 2 * MiB, WS_WFG = 4 * MiB, WS_LF = 5 * MiB, WS_SSQ = 7 * MiB, WS_FL2 = 9 * MiB - 0 * MiB;
constexpr size_t WS_W1IN = 12 * MiB, WS_W1OUT = 23 * MiB, WS_WMIX = 29 * MiB, WS_WOUT = 36 * MiB, WS_W2IN = 38 * MiB, WS_W2OUT = 49 * MiB;
constexpr size_t WS_XN = 64 * MiB, WS_H = 192 * MiB, WS_X2 = 640 * MiB, WS_XN2 = 896 * MiB, WS_END = 1024 * MiB;
constexpr size_t SEGSTRIDE = (size_t)T_ * 512;
static_assert(WS_FL2 + 2 * MiB <= WS_W1IN && WS_W2OUT + 6 * MiB <= WS_XN, "ws map");
constexpr int RING_BYTES = 131072, MISC_OFF = 2 * hg::IMG_BYTES, HG_AUX_OFF = MISC_OFF + 1024, LDS_BYTES = 147456;
static_assert(HG_AUX_OFF + 2 * hg::AUX_BYTES <= LDS_BYTES && attn_body::ATTN_LDS_BYTES <= RING_BYTES, "LDS map");
constexpr float LOG2E = 1.4426950408889634f;

struct Frame {
    LAS unsigned char* lds; volatile LAS unsigned* MISC;
    int tid, lane, wave, G;
    const float* in[19]; float* out; unsigned char* ws;
};
__device__ __forceinline__ float wave_sum(float v) {
#pragma unroll
    for (int o = 1; o < 64; o <<= 1) v += __shfl_xor(v, o);
    return v;
}
__device__ __forceinline__ unsigned f2bf(float f) { unsigned u = __builtin_bit_cast(unsigned, f); return (u + 0x7fffu + ((u >> 16) & 1u)) >> 16; }
__device__ __forceinline__ unsigned pk2(float lo, float hi) { return f2bf(lo) | (f2bf(hi) << 16); }
#define LDS_WAIT() asm volatile("s_waitcnt lgkmcnt(0)" ::: "memory")
#define XB_TMO      128
#define XB_XCNT(j)  (256  + 64 * (j))
#define XB_XSUB(j)  (1280 + 64 * (j))
#define XB_XGEN(j)  (2304 + 64 * (j))
#define XB_TOP      3328
#define XB_TOPGEN   3392
#define XCD_BAR_WORDS 3456
#define XB_SPIN_CAP (1u << 18)

__device__ __forceinline__ unsigned xb_ld(unsigned* p)              { return __hip_atomic_load(p, __ATOMIC_RELAXED, __HIP_MEMORY_SCOPE_AGENT); }
__device__ __forceinline__ unsigned xb_add(unsigned* p, unsigned v) { return __hip_atomic_fetch_add(p, v, __ATOMIC_RELAXED, __HIP_MEMORY_SCOPE_AGENT); }
__device__ __forceinline__ unsigned xb_xcc_id() { return (unsigned)__builtin_amdgcn_s_getreg((3 << 11) | 20) & 0xFu; }
#define XB_SPIN(cond, bar) do { unsigned _sp = 0; while (cond) { __builtin_amdgcn_s_sleep(1); \
    if ((++_sp & 255u) == 0u) { if (xb_ld(&(bar)[XB_TMO])) break; if (_sp > XB_SPIN_CAP) { atomicAdd(&(bar)[XB_TMO], 1u); break; } } } } while (0)

struct XcdBarrier {
    unsigned* bar; unsigned x;
    volatile LAS unsigned* st;
};

__device__ __forceinline__ XcdBarrier xcd_barrier_post(unsigned* bar, volatile LAS unsigned* st) {
    XcdBarrier b; b.bar = bar; b.x = xb_xcc_id(); b.st = st;
    if (threadIdx.x == 0) (void)xb_add(&bar[XB_XCNT(b.x)], 1u);
    return b;
}
__device__ __forceinline__ void xcd_barrier_complete(unsigned* bar, unsigned x, unsigned& nloc, unsigned& nx) {
    const unsigned G = gridDim.x * gridDim.y * gridDim.z;
    unsigned sum, cnt, mine, sp = 0u;
    for (;;) {
        sum = 0u; cnt = 0u; mine = 0u;
#pragma unroll
        for (unsigned j = 0; j < 16; ++j) { const unsigned c = xb_ld(&bar[XB_XCNT(j)]); sum += c; cnt += (c > 0u) ? 1u : 0u; mine = (j == x) ? c : mine; }
        if (sum == G) break;
        __builtin_amdgcn_s_sleep(1);
        if ((++sp & 255u) == 0u) { if (xb_ld(&bar[XB_TMO])) break; if (sp > XB_SPIN_CAP) { atomicAdd(&bar[XB_TMO], 1u); break; } }
    }
    nloc = mine > 0u ? mine : 1u; nx = cnt > 0u ? cnt : 1u;
}

__device__ __forceinline__ void xcd_barrier(const XcdBarrier& b) {
    asm volatile("s_waitcnt vmcnt(0)" ::: "memory");
    __syncthreads();
    if (threadIdx.x == 0) {
        unsigned* bar = b.bar;
        __builtin_amdgcn_s_waitcnt(0);
        unsigned nloc = b.st[0], nx = b.st[1];
        if (nloc == 0u) { xcd_barrier_complete(bar, b.x, nloc, nx); b.st[0] = nloc; b.st[1] = nx; }
        const unsigned old = xb_add(&bar[XB_XSUB(b.x)], 1u);
        const unsigned gen = old / nloc;
        if (old + 1u == (gen + 1u) * nloc) {
            __builtin_amdgcn_fence(__ATOMIC_RELEASE, "agent");
            asm volatile("s_waitcnt vmcnt(0)" ::: "memory");
            const unsigned og = xb_add(&bar[XB_TOP], 1u);
            const unsigned tg = og / nx;
            if (og + 1u == (tg + 1u) * nx) xb_add(&bar[XB_TOPGEN], 1u);
            else XB_SPIN(xb_ld(&bar[XB_TOPGEN]) == tg, bar);
            __builtin_amdgcn_fence(__ATOMIC_ACQUIRE, "agent");
            xb_add(&bar[XB_XGEN(b.x)], 1u);
            asm volatile("s_waitcnt vmcnt(0)" ::: "memory");
        } else {
            XB_SPIN(xb_ld(&bar[XB_XGEN(b.x)]) == gen, bar);
            __builtin_amdgcn_fence(__ATOMIC_ACQUIRE, "agent");
            asm volatile("s_waitcnt vmcnt(0)" ::: "memory");
        }
    }
    __syncthreads();
}

__device__ __forceinline__ void tr_item(const float* W, int ldw, int K, int k0, int n_src0, bf16* WT, int dst_row0, const float* ka, const float* kb, LAS float* scr, int lane) {
    float wv[32];
#pragma unroll
    for (int i = 0; i < 32; ++i) wv[i] = W[(size_t)(k0 + 2 * i + (lane >> 5)) * ldw + n_src0 + (lane & 31)];
#pragma unroll
    for (int i = 0; i < 32; ++i) { const int kk = 2 * i + (lane >> 5); float w = wv[i];
        if (ka) { const int k = k0 + kk; w *= (k < 512) ? ka[k] : kb[k - 512]; }
        scr[kk * 33 + (lane & 31)] = w; }
    LDS_WAIT(); asm volatile("" ::: "memory");
    const int c = lane & 7;
#pragma unroll
    for (int j = 0; j < 4; ++j) { const int n = (lane >> 3) + 8 * j; const LAS float* s = scr + (8 * c) * 33 + n;
        v4u o; o.x = pk2(s[0 * 33], s[1 * 33]); o.y = pk2(s[2 * 33], s[3 * 33]); o.z = pk2(s[4 * 33], s[5 * 33]); o.w = pk2(s[6 * 33], s[7 * 33]);
        *(v4u*)(WT + (size_t)(dst_row0 + n) * K + k0 + 8 * c) = o; }
    LDS_WAIT(); asm volatile("" ::: "memory");
}
__device__ __forceinline__ void p0_ffn_in_item(const float* W, bf16* WT, int r, LAS float* scr, int lane) {
    const int kb = r / 176, nb = r % 176, ns = 32 * nb; int dst;
    if (ns < FF_) dst = 256 * (ns / 128) + (ns % 128); else { const int c = ns - FF_; dst = 256 * (c / 128) + 128 + (c % 128); }
    tr_item(W, 2 * FF_, D_, 64 * kb, ns, WT, dst, nullptr, nullptr, scr, lane);
}
__device__ __forceinline__ void p0_mix_item(const float* W, bf16* WT, int r, LAS float* scr, int lane) {
    const int kb = r / 112, db = r % 112, seg = db >> 4, t = 32 * (db & 15), half = t >> 8, tt = t & 255;
    int feat = t; if (seg < 2) { const int bj = tt >> 7, wc = (tt & 127) >> 5; feat = 256 * half + 64 * wc + 32 * bj; }
    const int srcb = (seg < 3) ? 512 * seg : 1544 + 512 * (seg - 3);
    tr_item(W, 3592, D_, 64 * kb, srcb + feat, WT, 32 * db, nullptr, nullptr, scr, lane);
}
constexpr int P0_I_IN = 16 * 176, P0_I_OUT = 44 * 32, P0_I_MIX = 16 * 112, P0_I_WO = 16 * 32, P0_NITEMS = 2 * P0_I_IN + 2 * P0_I_OUT + P0_I_MIX + P0_I_WO;
__device__ __forceinline__ void p0_item(Frame& F, int it, LAS float* scr) {
    int r = it;
    if (r < P0_I_IN) { p0_ffn_in_item(F.in[5], (bf16*)(F.ws + WS_W1IN), r, scr, F.lane); return; } r -= P0_I_IN;
    if (r < P0_I_IN) { p0_ffn_in_item(F.in[17], (bf16*)(F.ws + WS_W2IN), r, scr, F.lane); return; } r -= P0_I_IN;
    if (r < P0_I_OUT) { tr_item(F.in[6], D_, FF_, 64 * (r / 32), 32 * (r % 32), (bf16*)(F.ws + WS_W1OUT), 32 * (r % 32), nullptr, nullptr, scr, F.lane); return; } r -= P0_I_OUT;
    if (r < P0_I_OUT) { tr_item(F.in[18], D_, FF_, 64 * (r / 32), 32 * (r % 32), (bf16*)(F.ws + WS_W2OUT), 32 * (r % 32), nullptr, nullptr, scr, F.lane); return; } r -= P0_I_OUT;
    if (r < P0_I_MIX) { p0_mix_item(F.in[8], (bf16*)(F.ws + WS_WMIX), r, scr, F.lane); return; } r -= P0_I_MIX;
    tr_item(F.in[15], D_, D_, 64 * (r / 32), 32 * (r % 32), (bf16*)(F.ws + WS_WOUT), 32 * (r % 32), F.in[12], F.in[14], scr, F.lane);
}
__device__ __forceinline__ void p0_prologue(Frame& F0) {
    Frame F = F0; { int t_ = threadIdx.x; asm volatile("" : "+v"(t_)); F.tid = t_; F.lane = t_ & 63; }
    float* mod = (float*)(F.ws + WS_MOD);
    for (int item = blockIdx.x; item < NMOD_ / 64; item += F.G) {
        LAS float* cs = (LAS float*)F.lds;
        for (int i = F.tid; i < NB_ * D_; i += 512) { const float c = F.in[1][i]; cs[i] = c / (1.0f + __expf(-c)); }
        __syncthreads();
        const int col = item * 64 + F.lane, k0 = F.wave * 128;
        float acc[32];
#pragma unroll
        for (int b = 0; b < 32; ++b) acc[b] = 0.f;
        const float* wp = F.in[2] + (size_t)k0 * NMOD_ + col;
#pragma unroll 1
        for (int k = 0; k < 128; k += 8) {
            float w[8];
#pragma unroll
            for (int j = 0; j < 8; ++j) w[j] = wp[(size_t)(k + j) * NMOD_];
#pragma unroll
            for (int b = 0; b < 32; ++b) { const f32x4 c4 = *(const LAS f32x4*)(cs + b * D_ + k0 + k); acc[b] += (c4[0] * w[0] + c4[1] * w[1]) + (c4[2] * w[2] + c4[3] * w[3]); }
            asm volatile("" ::: "memory");
#pragma unroll
            for (int b = 0; b < 32; ++b) { const f32x4 c4 = *(const LAS f32x4*)(cs + b * D_ + k0 + k + 4); acc[b] += (c4[0] * w[4] + c4[1] * w[5]) + (c4[2] * w[6] + c4[3] * w[7]); }
            asm volatile("" ::: "memory");
        }
        __syncthreads();
        LAS float* red = cs;
#pragma unroll
        for (int b = 0; b < 32; ++b) red[(F.wave * 32 + b) * 64 + F.lane] = acc[b];
        __syncthreads();
        for (int o = F.tid; o < 2048; o += 512) { const int b = o >> 6, l = o & 63; float s = 0.f;
#pragma unroll
            for (int w = 0; w < 8; ++w) s += red[(w * 32 + b) * 64 + l];
            mod[(size_t)b * NMOD_ + item * 64 + l] = s + F.in[3][item * 64 + l]; }
        __syncthreads();
    }
    { float* wfg = (float*)(F.ws + WS_WFG); const int gi = blockIdx.x * 512 + F.tid;
      for (int i = gi; i < 8 * D_; i += F.G * 512) wfg[i] = F.in[8][(size_t)(i & 1023) * 3592 + 1536 + (i >> 10)]; }
    LAS float* scr = (LAS float*)(F.lds + F.wave * 16384);
    const int gw = blockIdx.x * 8 + F.wave, NGW = F.G * 8;
    constexpr int NITEMS = P0_NITEMS, NA = 6912;
    if (F.G > NMOD_ / 64 + 16) {
        for (int it = gw; it < NA; it += NGW) p0_item(F, it, scr);
        if ((int)blockIdx.x >= NMOD_ / 64) { const int gw2 = ((int)blockIdx.x - NMOD_ / 64) * 8 + F.wave, NGW2 = (F.G - NMOD_ / 64) * 8;
            for (int it = NA + gw2; it < NITEMS; it += NGW2) p0_item(F, it, scr); }
    } else for (int it = gw; it < NITEMS; it += NGW) p0_item(F, it, scr);
}
template <bool SRCB> __device__ __forceinline__ f32x4 ld_row4(const float* src, size_t e) {
    if (!SRCB) return __builtin_nontemporal_load((const f32x4*)(src + e));
    const unsigned long long w = *(const unsigned long long*)((const bf16*)src + e); const unsigned lo = (unsigned)w, hi = (unsigned)(w >> 32);
    return (f32x4){__uint_as_float(lo << 16), __uint_as_float(lo & 0xffff0000u), __uint_as_float(hi << 16), __uint_as_float(hi & 0xffff0000u)};
}
template <int MODE, bool SRCB> __device__ __forceinline__ void norm_phase(Frame& F0, const float* src, const float* g, int sh_chunk, int sc_chunk) {
    Frame F = F0; { int t_ = threadIdx.x; asm volatile("" : "+v"(t_)); F.tid = t_; F.lane = t_ & 63; }
    const float* mod = (const float*)(F.ws + WS_MOD); bf16* XN = (bf16*)(F.ws + WS_XN);
    LAS float* wl = (LAS float*)F.lds;
    if (MODE == 1) { const float* wfg = (const float*)(F.ws + WS_WFG); for (int i = F.tid; i < 8 * D_; i += 512) wl[i] = wfg[i]; __syncthreads(); }
    const int gw = blockIdx.x * 8 + F.wave, NGW = F.G * 8;
    for (int r0 = gw * 32; r0 < T_; r0 += NGW * 32) {
        const int b = r0 / SEQ_; const float* mp = mod + (size_t)b * NMOD_;
        f32x4 A[4], Bv[4];
#pragma unroll
        for (int j = 0; j < 4; ++j) { const int col = 4 * F.lane + 256 * j; const f32x4 gg = *(const f32x4*)(g + col), sc = *(const f32x4*)(mp + sc_chunk * D_ + col);
            A[j] = gg * (sc + 1.0f); Bv[j] = *(const f32x4*)(mp + sh_chunk * D_ + col); }
        f32x4 nv[4];
#pragma unroll
        for (int j = 0; j < 4; ++j) nv[j] = ld_row4<SRCB>(src, (size_t)r0 * D_ + 4 * F.lane + 256 * j);
        for (int r = r0; r < r0 + 32; ++r) {
            f32x4 v[4]; float ss = 0.f;
#pragma unroll
            for (int j = 0; j < 4; ++j) { v[j] = nv[j]; ss += (v[j][0] * v[j][0] + v[j][1] * v[j][1]) + (v[j][2] * v[j][2] + v[j][3] * v[j][3]); }
            if (r + 1 < r0 + 32) {
#pragma unroll
                for (int j = 0; j < 4; ++j) nv[j] = ld_row4<SRCB>(src, (size_t)(r + 1) * D_ + 4 * F.lane + 256 * j); }
            const float rstd = 1.0f / sqrtf(wave_sum(ss) * (1.0f / D_) + 1e-6f);
#pragma unroll
            for (int j = 0; j < 4; ++j) { v[j] = v[j] * rstd * A[j] + Bv[j];
                *(unsigned long long*)(XN + (size_t)r * D_ + 4 * F.lane + 256 * j) = (unsigned long long)pk2(v[j][0], v[j][1]) | ((unsigned long long)pk2(v[j][2], v[j][3]) << 32); }
            if (MODE == 1) {
                float d[8];
#pragma unroll
                for (int h = 0; h < 8; ++h) { float s = 0.f;
#pragma unroll
                    for (int j = 0; j < 4; ++j) { const f32x4 w = *(const LAS f32x4*)(wl + h * D_ + 4 * F.lane + 256 * j); s += (v[j][0] * w[0] + v[j][1] * w[1]) + (v[j][2] * w[2] + v[j][3] * w[3]); }
                    d[h] = wave_sum(s); }
                float z = d[0];
#pragma unroll
                for (int h = 1; h < 8; ++h) z = (F.lane == h) ? d[h] : z;
                if (F.lane < 8) { z += F.in[9][F.lane]; ((float*)(F.ws + WS_LF))[(size_t)r * 8 + F.lane] = fminf(z, 0.f) - __logf(1.0f + __expf(-fabsf(z))); }
            }
        }
    }
    if (MODE == 1) __syncthreads();
}
__device__ __forceinline__ void fscan_phase(Frame& F0) {
    Frame F = F0; { int t_ = threadIdx.x; asm volatile("" : "+v"(t_)); F.tid = t_; F.lane = t_ & 63; }
    const float* LF = (const float*)(F.ws + WS_LF); float* FL2 = (float*)(F.ws + WS_FL2);
    LAS float* wsum = (LAS float*)F.lds;
    for (int bh = blockIdx.x; bh < 256; bh += F.G) { const int b = bh >> 3, h = bh & 7;
        float p[4]; float a = 0.f;
#pragma unroll
        for (int i = 0; i < 4; ++i) { a += LF[((size_t)b * SEQ_ + 4 * F.tid + i) * 8 + h]; p[i] = a; }
        float incl = a;
#pragma unroll
        for (int o = 1; o < 64; o <<= 1) { const float t = __shfl_up(incl, o); if (F.lane >= o) incl += t; }
        if (F.lane == 63) wsum[F.wave] = incl;
        __syncthreads();
        float woff = 0.f;
#pragma unroll
        for (int w = 0; w < 8; ++w) woff += (w < F.wave) ? wsum[w] : 0.f;
        const float ex = woff + incl - a;
        f32x4 o4; o4[0] = (ex + p[0]) * LOG2E; o4[1] = (ex + p[1]) * LOG2E; o4[2] = (ex + p[2]) * LOG2E; o4[3] = (ex + p[3]) * LOG2E;
        *(f32x4*)(FL2 + (size_t)bh * SEQ_ + 4 * F.tid) = o4;
        __syncthreads();
    }
}

#ifndef PHASE_MASK
#define PHASE_MASK 0x7ff
#endif
#ifndef P6SEL
#define P6SEL 0
#endif
#ifndef REPEAT_MASK
#define REPEAT_MASK 0
#endif
#define PH(k) if constexpr (((PHASE_MASK) >> (k)) & 1) for (int rep_ = 0; rep_ < 1 + (((REPEAT_MASK) >> (k)) & 1); ++rep_)
struct Args { const float* in[19]; float* out; unsigned char* ws; int pad0, pad1; };
__global__ void __launch_bounds__(512, 2) fwd_mega(Args args) {
    extern __shared__ __attribute__((aligned(16))) unsigned char lds[];
    cg::grid_group grid = cg::this_grid();
    Frame F;
    F.lds = (LAS unsigned char*)lds; F.MISC = (volatile LAS unsigned*)(F.lds + MISC_OFF);
    F.tid = threadIdx.x; F.lane = F.tid & 63; F.wave = __builtin_amdgcn_readfirstlane(F.tid >> 6); F.G = gridDim.x;
#pragma unroll
    for (int i = 0; i < 19; ++i) F.in[i] = args.in[i];
    F.out = args.out; F.ws = args.ws;
    unsigned char* ws = args.ws;
    float* mod = (float*)(ws + WS_MOD);
    bf16* XN = (bf16*)(ws + WS_XN); bf16* HB = (bf16*)(ws + WS_H); bf16* PJ = (bf16*)(ws + WS_H); float* X2 = (float*)(ws + WS_X2);
    const int bid = (int)blockIdx.x;
    if (threadIdx.x < 16) F.MISC[threadIdx.x] = 0u;
    __syncthreads();
    const XcdBarrier xbar = xcd_barrier_post((unsigned*)(ws + WS_CTL + 16384), F.MISC + 8);
#define GSYNC() xcd_barrier(xbar)

    PH(0) p0_prologue(F);
    grid.sync();
#ifdef SYNC_PROBE
    for (int i_ = 0; i_ < 20; ++i_) grid.sync();
#endif
    PH(1) norm_phase<0, false>(F, F.in[0], F.in[4], 0, 1);
    GSYNC();
    PH(2) { pg8::Gemm g{XN, (const bf16*)(ws + WS_W1IN), T_, 2 * FF_, D_}; pg8::StaticOrder S; S.init(T_, 2 * FF_, F.G, bid);
      pg8::EpiSwiGLU E{HB, FF_};
      pg8::gemm_phase<pg8::EpiSwiGLU, pg8::StaticOrder, true, true>(F.lds, g, S, E); }
    GSYNC();
    PH(3) { pg8::Gemm g{HB, (const bf16*)(ws + WS_W1OUT), T_, D_, FF_, 1}; pg8::StaticOrder S; S.init(T_, D_, F.G, bid);
      pg8::EpiResid<false> E{F.in[0], F.out, mod + 2 * D_, 0.5f, nullptr};
      pg8::gemm_phase<pg8::EpiResid<false>, pg8::StaticOrder, true, true>(F.lds, g, S, E); }
    GSYNC();
    PH(4) norm_phase<1, false>(F, F.out, F.in[7], 3, 4);
    GSYNC();
    PH(5) fscan_phase(F);
    PH(5) { pg8::Gemm g{XN, (const bf16*)(ws + WS_WMIX), T_, NMIX_, D_}; pg8::StaticOrder S; S.init(T_, NMIX_, F.G, bid);
      pg8::EpiMix E{PJ, SEGSTRIDE, F.in[10], F.in[11], F.in[13], attn_body::C2};
      pg8::gemm_phase<pg8::EpiMix, pg8::StaticOrder, true, true>(F.lds, g, S, E); }
    GSYNC();
    PH(6) {
        const int xl = bid & 7;
        unsigned* q = (unsigned*)(ws + WS_CTL) + 1024 * rep_ + 64 * xl;
        const attn_body::bf16* Qp = (const attn_body::bf16*)PJ; const attn_body::bf16* Kp = Qp + SEGSTRIDE; const attn_body::bf16* Vp = Qp + 2 * SEGSTRIDE;
        for (;;) {
            if (threadIdx.x == 0) F.MISC[0] = atomicAdd(q, 1u);
            __syncthreads();
            const int idx = (int)F.MISC[0];
            __syncthreads();
            if (idx >= 16 + 256) break;
            if (idx < 16) { if (!(rep_ == 1 && P6SEL >= 2)) hg::hgrn_unit(xl + 8 * idx, PJ + 3 * SEGSTRIDE, PJ + 4 * SEGSTRIDE, PJ + 5 * SEGSTRIDE, PJ + 6 * SEGSTRIDE, XN, F.lds, F.lds + HG_AUX_OFF); }
            else if (!(rep_ == 1 && P6SEL == 1)) { const int a = idx - 16, bh = xl + 8 * (a & 31), qb = 7 - (a >> 5);
                const float* Fg = (const float*)(ws + WS_FL2) + (size_t)bh * SEQ_;
                attn_body::attn_unit<90, true>(bh >> 3, bh & 7, qb, Qp, Kp, Vp, (attn_body::bf16*)XN, Fg, (float*)(ws + WS_SSQ), (char*)lds); }
        }
    }
    GSYNC();
    PH(7) { pg8::Gemm g{XN, (const bf16*)(ws + WS_WOUT), T_, D_, D_}; pg8::StaticOrder S; S.init(T_, D_, F.G, bid);
      typedef pg8::EpiResidNorm<true> EN; static_assert(EN::O_MOD == WS_MOD && EN::O_LF == WS_LF && EN::O_SSQ == WS_SSQ && EN::O_XN2 == WS_XN2 && EN::O_CNT == WS_CTL + 65536, "fused-norm epilogue vs the workspace map");
      pg8::EpiResidNorm<true> E{F.out, X2, ws, F.in[16], 1.0f};
      pg8::gemm_phase<pg8::EpiResidNorm<true>, pg8::StaticOrder, true, true>(F.lds, g, S, E); }
    GSYNC();
    PH(9) { pg8::Gemm g{(const bf16*)(ws + WS_XN2), (const bf16*)(ws + WS_W2IN), T_, 2 * FF_, D_}; pg8::StaticOrder S; S.init(T_, 2 * FF_, F.G, bid);
      pg8::EpiSwiGLU E{HB, FF_};
      pg8::gemm_phase<pg8::EpiSwiGLU, pg8::StaticOrder, true, true>(F.lds, g, S, E); }
    GSYNC();
    PH(10) { pg8::Gemm g{HB, (const bf16*)(ws + WS_W2OUT), T_, D_, FF_, 1}; pg8::StaticOrder S; S.init(T_, D_, F.G, bid);
      pg8::EpiResid<false> E{X2, F.out, mod + 8 * D_, 0.5f, nullptr};
      pg8::gemm_phase<pg8::EpiResid<false>, pg8::StaticOrder, true, true>(F.lds, g, S, E); }
}

extern "C" void kernel_launch(void* const* d_in, const int* in_sizes, int n_in, void* d_out, int out_size, void* d_ws, size_t ws_size, hipStream_t stream) {
    static int grid = 0;
    if (grid == 0) {
        int dev = 0, cus = 0, per_cu = 0;
        if (n_in != 19 || out_size != T_ * D_ || ws_size < WS_END) { fprintf(stderr, "kernel_launch: unexpected shapes (n_in %d out %d ws %zu)\n", n_in, out_size, ws_size); grid = -1; return; }
        (void)hipGetDevice(&dev);
        (void)hipDeviceGetAttribute(&cus, hipDeviceAttributeMultiprocessorCount, dev);
        (void)hipFuncSetAttribute((const void*)fwd_mega, hipFuncAttributeMaxDynamicSharedMemorySize, LDS_BYTES);
        (void)hipOccupancyMaxActiveBlocksPerMultiprocessor(&per_cu, (const void*)fwd_mega, 512, LDS_BYTES);
        (void)hipGetLastError();
        grid = cus > 0 ? cus : 256;
        fprintf(stderr, "kernel_launch: cus %d per_cu %d grid %d ws %zu\n", cus, per_cu, grid, ws_size);
    }
    if (grid < 0) return;
    (void)hipMemsetAsync((char*)d_ws + WS_CTL, 0, 131072, stream);
    Args a{};
    for (int i = 0; i < 19; ++i) a.in[i] = (const float*)d_in[i];
    a.out = (float*)d_out; a.ws = (unsigned char*)d_ws;
    void* args[] = {&a};
    hipError_t e = hipLaunchCooperativeKernel((const void*)fwd_mega, dim3(grid), dim3(512), args, LDS_BYTES, stream);
    if (e != hipSuccess) fprintf(stderr, "cooperative launch failed: %s (grid %d)\n", hipGetErrorString(e), grid);
}
```

```cpp
#include <hip/hip_runtime.h>
#include <hip/hip_cooperative_groups.h>
#include <cstdio>
#include <cstdint>
namespace cg = cooperative_groups;
namespace pg8 {
#define PG8_LAS __attribute__((address_space(3)))
typedef unsigned short bf16_t;
typedef short bf16x8 __attribute__((ext_vector_type(8)));
typedef float f32x4 __attribute__((ext_vector_type(4)));
typedef unsigned u32x4 __attribute__((ext_vector_type(4)));
constexpr int BM = 256, BK = 64, HALF = 128, HTB = HALF * BK * 2  , STAGE_BYTES = 8 * HTB, NXCD = 8, WGM = 4;

__host__ __device__ __forceinline__ int lds_byte(int r, int c) { const int st = (r >> 4) * 2 + (c >> 5), rr = r & 15, cc = c & 31, ob = rr * 64 + cc * 2; return st * 1024 + (ob ^ (((ob >> 9) & 1) << 5)); }
__host__ __device__ __forceinline__ void stage_rc(int b, int& R, int& C) { const int st = b / 1024, sb = b % 1024, swz = sb ^ (((sb >> 9) & 1) << 5); R = (st >> 1) * 16 + swz / 64; C = (st & 1) * 32 + (swz % 64) / 2; }
__host__ __device__ __forceinline__ int perm32(int rho) { const int n = rho >> 4, i = rho & 15; return 8 * (i >> 2) + 4 * n + (i & 3); }

struct Unit { int pm, pn; };
struct Gemm { const bf16_t* A; const bf16_t* Bt; int M, N, K; int atile; };

struct StaticOrder {
    int nM, nN, nwg, G, c;
    __host__ __device__ void init(int M, int N, int G_, int c_) { nM = M / BM; nN = N / BM; nwg = nM * nN; G = G_; c = c_; }
    __host__ __device__ bool next(int i, Unit& u) const {
        const long L = (long)i * G + c; if (L >= nwg) return false;
        int wgid = (int)L; { const int q = nwg / NXCD, r = nwg % NXCD, xcd = wgid % NXCD, off = wgid / NXCD; wgid = (xcd < r ? xcd * (q + 1) : r * (q + 1) + (xcd - r) * q) + off; }
        const int nig = WGM * nN, gid = wgid / nig, fm = gid * WGM, gsz = (nM - fm) < WGM ? (nM - fm) : WGM;
        u.pm = fm + ((wgid % nig) % gsz); u.pn = (wgid % nig) / gsz; return true;
    }
    __device__ __forceinline__ void a_ready(const Unit&) const {}
    __device__ __forceinline__ void done(const Unit&) const {}
};

__device__ __forceinline__ unsigned cvt_pk_bf16(float lo, float hi) { unsigned r; asm volatile("v_cvt_pk_bf16_f32 %0, %1, %2" : "=v"(r) : "v"(lo), "v"(hi)); return r; }
typedef float f32x2 __attribute__((ext_vector_type(2)));
__device__ __forceinline__ float silu_f(float x) { return x * __builtin_amdgcn_rcpf(1.0f + __expf(-x)); }
struct EpiSwiGLU {
    static constexpr bool PERM = true, AFTER_DRAIN = false, MID = false; static constexpr int MID_T = -1; static constexpr bool SPLIT = true, FUSEDN = false;
    bf16_t* O; int ldc;
    __device__ __forceinline__ void mid(f32x4 (&)[2][2][4][2], const Unit&, int, int) const {}
    __device__ __forceinline__ void operator()(const f32x4 (&acc)[2][2][4][2], const Unit& u, int wr, int wc, int fr, int fq) const {
        const int ln = fr + 16 * fq, srcl = 4 * ((ln >> 2) + 16 * (ln & 3));
        bf16_t* blk0 = O + ((size_t)(u.pm * 16 + wr * 4) * (ldc >> 5) + u.pn * 4 + wc) * 512 + ln * 8;
#pragma unroll
        for (int ai = 0; ai < 2; ++ai)
#pragma unroll
            for (int m = 0; m < 4; ++m) { bf16_t* p = blk0 + (size_t)(ai * 8 + m) * (ldc >> 5) * 512;
                const f32x4 g0 = acc[ai][0][m][0], g1 = acc[ai][0][m][1], u0 = acc[ai][1][m][0], u1 = acc[ai][1][m][1];
                u32x4 w; w.x = cvt_pk_bf16(silu_f(g0[0]) * u0[0], silu_f(g0[1]) * u0[1]); w.y = cvt_pk_bf16(silu_f(g0[2]) * u0[2], silu_f(g0[3]) * u0[3]);
                w.z = cvt_pk_bf16(silu_f(g1[0]) * u1[0], silu_f(g1[1]) * u1[1]); w.w = cvt_pk_bf16(silu_f(g1[2]) * u1[2], silu_f(g1[3]) * u1[3]);
                u32x4 wp; wp.x = (unsigned)__builtin_amdgcn_ds_bpermute(srcl, (int)w.x); wp.y = (unsigned)__builtin_amdgcn_ds_bpermute(srcl, (int)w.y); wp.z = (unsigned)__builtin_amdgcn_ds_bpermute(srcl, (int)w.z); wp.w = (unsigned)__builtin_amdgcn_ds_bpermute(srcl, (int)w.w);
                __builtin_nontemporal_store(wp, (u32x4*)p); }
    }
};
template <bool MIDF> struct EpiResid {
    static constexpr bool PERM = true, AFTER_DRAIN = false, MID = MIDF; static constexpr int MID_T = 8; static constexpr bool SPLIT = false, FUSEDN = false;
    const float* base; float* out; const float* gate; float coef; const float* ssq;
    __device__ __forceinline__ void mid(f32x4 (&acc)[2][2][4][2], const Unit& u, int wr, int fr) const {
#pragma unroll
        for (int ai = 0; ai < 2; ++ai)
#pragma unroll
            for (int m = 0; m < 4; ++m) { const size_t row = (size_t)(u.pm * BM + ai * HALF + wr * 64 + m * 16 + fr);
                const f32x4 a = *(const f32x4*)(ssq + row * 8), b = *(const f32x4*)(ssq + row * 8 + 4);
                const float s = ((a[0] + a[1]) + (a[2] + a[3])) + ((b[0] + b[1]) + (b[2] + b[3]));
                const float rs = 1.0f / sqrtf(s * (1.0f / 512.0f) + 1e-6f);
#pragma unroll
                for (int bj = 0; bj < 2; ++bj)
#pragma unroll
                    for (int n = 0; n < 2; ++n) acc[ai][bj][m][n] = acc[ai][bj][m][n] * rs; }
    }
    __device__ __forceinline__ void operator()(const f32x4 (&acc)[2][2][4][2], const Unit& u, int wr, int wc, int fr, int fq) const {
        const int b = u.pm >> 3; const float* gp = gate + (size_t)b * 9216; const int col0 = u.pn * BM + wc * 32 + 8 * fq;
        f32x4 gv[2][2];
#pragma unroll
        for (int bj = 0; bj < 2; ++bj)
#pragma unroll
            for (int n = 0; n < 2; ++n) gv[bj][n] = *(const f32x4*)(gp + col0 + bj * HALF + n * 4) * coef;
#pragma unroll
        for (int ai = 0; ai < 2; ++ai)
#pragma unroll
            for (int m = 0; m < 4; ++m) { const size_t off = (size_t)(u.pm * BM + ai * HALF + wr * 64 + m * 16 + fr) * 1024 + col0;
#pragma unroll
                for (int bj = 0; bj < 2; ++bj)
#pragma unroll
                    for (int n = 0; n < 2; ++n) { const f32x4 bs = *(const f32x4*)(base + off + bj * HALF + n * 4); *(f32x4*)(out + off + bj * HALF + n * 4) = bs + gv[bj][n] * acc[ai][bj][m][n]; }
                if (m & 1) asm volatile("" ::: "memory"); }
    }
};
template <bool MIDF> struct EpiResidNorm {
    static constexpr bool PERM = true, AFTER_DRAIN = false, MID = MIDF; static constexpr int MID_T = 8; static constexpr bool SPLIT = false, FUSEDN = true;
    const float* base; float* out; unsigned char* ws; const float* gn; float coef;
    static constexpr size_t O_MOD = (size_t)2 << 20, O_LF = (size_t)5 << 20, O_SSQ = (size_t)7 << 20, O_XN2 = (size_t)896 << 20, O_CNT = 65536;
    static constexpr int C_GATE = 5, C_SH = 6, C_SC = 7;
    __device__ __forceinline__ void mid(f32x4 (&acc)[2][2][4][2], const Unit& u, int wr, int fr_) const {
        int fr = fr_; asm volatile("" : "+v"(fr));
#pragma unroll
        for (int ai = 0; ai < 2; ++ai)
#pragma unroll
            for (int m = 0; m < 4; ++m) { const size_t row = (size_t)(u.pm * BM + ai * HALF + wr * 64 + m * 16 + fr);
                const float* ssq = (const float*)(ws + O_SSQ); const f32x4 a = *(const f32x4*)(ssq + row * 8), b = *(const f32x4*)(ssq + row * 8 + 4);
                const float s = ((a[0] + a[1]) + (a[2] + a[3])) + ((b[0] + b[1]) + (b[2] + b[3]));
                const float rs = 1.0f / sqrtf(s * (1.0f / 512.0f) + 1e-6f);
#pragma unroll
                for (int bj = 0; bj < 2; ++bj)
#pragma unroll
                    for (int n = 0; n < 2; ++n) acc[ai][bj][m][n] = acc[ai][bj][m][n] * rs; }
    }
    __device__ __forceinline__ void fusedn(f32x4 (&acc)[2][2][4][2], const Unit& u, int wr, int wc, int fr_, int fq_, PG8_LAS unsigned char* lds, int wid, int lane_) const {
        int fr = fr_, fq = fq_, lane = lane_; asm volatile("" : "+v"(fr), "+v"(fq), "+v"(lane));
        PG8_LAS float* P = (PG8_LAS float*)(lds + 140288);
        PG8_LAS float* S = P + 1024;
        const int b = u.pm >> 3; const float* modb = (const float*)(ws + O_MOD) + (size_t)b * 9216; const float* gp = modb + C_GATE * 1024; const int col0 = u.pn * BM + wc * 32 + 8 * fq;
        unsigned* slots = (unsigned*)(ws + O_LF); unsigned* cnt = (unsigned*)(ws + O_CNT); bf16_t* xn = (bf16_t*)(ws + O_XN2);
        f32x4 gv[2][2];
#pragma unroll
        for (int bj = 0; bj < 2; ++bj)
#pragma unroll
            for (int n = 0; n < 2; ++n) gv[bj][n] = *(const f32x4*)(gp + col0 + bj * HALF + n * 4) * coef;
#pragma unroll
        for (int ai = 0; ai < 2; ++ai)
#pragma unroll
            for (int m = 0; m < 4; ++m) { const size_t off = (size_t)(u.pm * BM + ai * HALF + wr * 64 + m * 16 + fr) * 1024 + col0; float s = 0.f;
#pragma unroll
                for (int bj = 0; bj < 2; ++bj)
#pragma unroll
                    for (int n = 0; n < 2; ++n) { const f32x4 bs = *(const f32x4*)(base + off + bj * HALF + n * 4); const f32x4 o = bs + gv[bj][n] * acc[ai][bj][m][n];
                        acc[ai][bj][m][n] = o; s += (o[0] * o[0] + o[1] * o[1]) + (o[2] * o[2] + o[3] * o[3]); }
                s += __shfl_xor(s, 16); s += __shfl_xor(s, 32);
                if (fq == 0) P[(ai * HALF + wr * 64 + m * 16 + fr) * 4 + wc] = s;
                asm volatile("" ::: "memory"); }
        asm volatile("s_waitcnt lgkmcnt(0)" ::: "memory"); __builtin_amdgcn_s_barrier(); asm volatile("" ::: "memory");
        const int row = wid * 32 + (lane & 31);
        if (lane < 32) { const f32x4 p = *(const PG8_LAS f32x4*)(P + row * 4);
            __hip_atomic_store(slots + ((size_t)(u.pm * BM + row) * 4 + u.pn), __float_as_uint((p[0] + p[1]) + (p[2] + p[3])), __ATOMIC_RELAXED, __HIP_MEMORY_SCOPE_AGENT); }
        asm volatile("s_waitcnt vmcnt(0)" ::: "memory");
        if (lane == 0) __hip_atomic_fetch_add(cnt + 64 * u.pm, 1u, __ATOMIC_RELAXED, __HIP_MEMORY_SCOPE_AGENT);
#pragma unroll
        for (int ai = 0; ai < 2; ++ai)
#pragma unroll
            for (int m = 0; m < 4; ++m) { const size_t off = (size_t)(u.pm * BM + ai * HALF + wr * 64 + m * 16 + fr) * 1024 + col0;
#pragma unroll
                for (int bj = 0; bj < 2; ++bj)
#pragma unroll
                    for (int n = 0; n < 2; ++n) *(f32x4*)(out + off + bj * HALF + n * 4) = acc[ai][bj][m][n]; }
        if (wid == 0) { unsigned sp = 0;
            while ((unsigned)__builtin_amdgcn_readfirstlane(__hip_atomic_load(cnt + 64 * u.pm, __ATOMIC_RELAXED, __HIP_MEMORY_SCOPE_AGENT)) < 32u) { __builtin_amdgcn_s_sleep(2); if (++sp > (1u << 24)) break; }
            __builtin_amdgcn_fence(__ATOMIC_ACQUIRE, "agent"); }
        asm volatile("s_waitcnt vmcnt(0) lgkmcnt(0)" ::: "memory"); __builtin_amdgcn_s_barrier(); asm volatile("" ::: "memory");
        if (lane < 32) { const unsigned* sl = slots + (size_t)(u.pm * BM + row) * 4; float t = 0.f;
#pragma unroll
            for (int k = 0; k < 4; ++k) t += __uint_as_float(__hip_atomic_load(sl + k, __ATOMIC_RELAXED, __HIP_MEMORY_SCOPE_AGENT));
            S[row] = 1.0f / sqrtf(t * (1.0f / 1024.0f) + 1e-6f); }
        asm volatile("s_waitcnt lgkmcnt(0)" ::: "memory"); __builtin_amdgcn_s_barrier(); asm volatile("" ::: "memory");
#pragma unroll
        for (int bj = 0; bj < 2; ++bj) { f32x4 An[2], Bn[2];
#pragma unroll
            for (int n = 0; n < 2; ++n) { const int c = col0 + bj * HALF + n * 4; const f32x4 g4 = *(const f32x4*)(gn + c), s4 = *(const f32x4*)(modb + C_SC * 1024 + c);
                An[n] = g4 * (s4 + 1.0f); Bn[n] = *(const f32x4*)(modb + C_SH * 1024 + c); }
#pragma unroll
            for (int ai = 0; ai < 2; ++ai)
#pragma unroll
                for (int m = 0; m < 4; ++m) { const int rl = ai * HALF + wr * 64 + m * 16 + fr; const float r = S[rl]; const size_t off = (size_t)(u.pm * BM + rl) * 1024 + col0;
                    const f32x4 v0 = acc[ai][bj][m][0] * r * An[0] + Bn[0], v1 = acc[ai][bj][m][1] * r * An[1] + Bn[1];
                    u32x4 w; w.x = cvt_pk_bf16(v0[0], v0[1]); w.y = cvt_pk_bf16(v0[2], v0[3]); w.z = cvt_pk_bf16(v1[0], v1[1]); w.w = cvt_pk_bf16(v1[2], v1[3]);
                    *(u32x4*)(xn + off + bj * HALF) = w; }
            asm volatile("" ::: "memory"); }
    }
};
struct EpiMix {
    static constexpr bool PERM = true, AFTER_DRAIN = false, MID = false; static constexpr int MID_T = -1; static constexpr bool SPLIT = false, FUSEDN = false;
    bf16_t* P; size_t segstride; const float* qg; const float* kg; const float* lbl; float c2;
    __device__ __forceinline__ void mid(f32x4 (&)[2][2][4][2], const Unit&, int, int) const {}
    __device__ __forceinline__ void operator()(const f32x4 (&acc)[2][2][4][2], const Unit& u, int wr, int wc, int fr, int fq) const {
        const int seg = u.pn >> 1, half = u.pn & 1;
        bf16_t* base = P + (size_t)seg * segstride + (size_t)(u.pm * BM + wr * 64 + fr) * 512 + 256 * half;
        if (seg < 2) {
            const float* g = seg == 0 ? qg : kg; const float sc = seg == 0 ? c2 : 1.0f;
            f32x4 gn[2][2];
#pragma unroll
            for (int bj = 0; bj < 2; ++bj)
#pragma unroll
                for (int n = 0; n < 2; ++n) gn[bj][n] = *(const f32x4*)(g + 32 * bj + 8 * fq + 4 * n) * sc;
#pragma unroll
            for (int ai = 0; ai < 2; ++ai)
#pragma unroll
                for (int m = 0; m < 4; ++m) { float ss = 0.f;
#pragma unroll
                    for (int bj = 0; bj < 2; ++bj)
#pragma unroll
                        for (int n = 0; n < 2; ++n) { const f32x4 x = acc[ai][bj][m][n]; ss += (x[0] * x[0] + x[1] * x[1]) + (x[2] * x[2] + x[3] * x[3]); }
                    ss += __shfl_xor(ss, 16); ss += __shfl_xor(ss, 32);
                    const float rs = 1.0f / sqrtf(ss * (1.0f / 64.0f) + 1e-6f);
#pragma unroll
                    for (int bj = 0; bj < 2; ++bj) { const f32x4 v0 = acc[ai][bj][m][0] * gn[bj][0] * rs, v1 = acc[ai][bj][m][1] * gn[bj][1] * rs;
                        u32x4 w; w.x = cvt_pk_bf16(v0[0], v0[1]); w.y = cvt_pk_bf16(v0[2], v0[3]); w.z = cvt_pk_bf16(v1[0], v1[1]); w.w = cvt_pk_bf16(v1[2], v1[3]);
                        if (seg == 0) __builtin_nontemporal_store(w, (u32x4*)(base + (size_t)(ai * HALF + m * 16) * 512 + 64 * wc + 32 * bj + 8 * fq));
                        else *(u32x4*)(base + (size_t)(ai * HALF + m * 16) * 512 + 64 * wc + 32 * bj + 8 * fq) = w; } }
        } else {
            const int cw = wc * 32 + 8 * fq;
            f32x4 om[2][2];
#pragma unroll
            for (int bj = 0; bj < 2; ++bj)
#pragma unroll
                for (int n = 0; n < 2; ++n) { om[bj][n] = (f32x4){1.f, 1.f, 1.f, 1.f};
                    if (seg == 4) { const int c = 256 * half + 128 * bj + cw + 4 * n; const f32x4 l0 = *(const f32x4*)(lbl + c), l1 = *(const f32x4*)(lbl + 512 + c);
#pragma unroll
                        for (int e = 0; e < 4; ++e) om[bj][n][e] = __builtin_amdgcn_rcpf(1.0f + __expf(l0[e] - l1[e])); } }
#pragma unroll
            for (int ai = 0; ai < 2; ++ai)
#pragma unroll
                for (int m = 0; m < 4; ++m)
#pragma unroll
                    for (int bj = 0; bj < 2; ++bj) { f32x4 v0 = acc[ai][bj][m][0], v1 = acc[ai][bj][m][1];
                        if (seg == 3 || seg == 6) {
#pragma unroll
                            for (int e = 0; e < 4; ++e) { v0[e] = silu_f(v0[e]); v1[e] = silu_f(v1[e]); }
                        } else if (seg == 4) {
#pragma unroll
                            for (int e = 0; e < 4; ++e) { v0[e] = om[bj][0][e] * __builtin_amdgcn_rcpf(1.0f + __expf(v0[e])); v1[e] = om[bj][1][e] * __builtin_amdgcn_rcpf(1.0f + __expf(v1[e])); }
                        }
                        u32x4 w; w.x = cvt_pk_bf16(v0[0], v0[1]); w.y = cvt_pk_bf16(v0[2], v0[3]); w.z = cvt_pk_bf16(v1[0], v1[1]); w.w = cvt_pk_bf16(v1[2], v1[3]);
                        if (seg >= 3) __builtin_nontemporal_store(w, (u32x4*)(base + (size_t)(ai * HALF + m * 16) * 512 + 128 * bj + cw));
                        else *(u32x4*)(base + (size_t)(ai * HALF + m * 16) * 512 + 128 * bj + cw) = w; }
        }
    }
};
template <class Epi, class Sched, bool ALIGN_EPI = false, bool SP2 = false>
__device__ __forceinline__ void gemm_phase(PG8_LAS unsigned char* lds, const Gemm g, const Sched& S, const Epi& E) {
    int tid_ = threadIdx.x; asm volatile("" : "+v"(tid_));
    const int tid = tid_, wid = __builtin_amdgcn_readfirstlane(tid >> 6), lane = tid & 63, wr = wid >> 2, wc = wid & 3, fr = lane & 15, fq = lane >> 4;
    const int K = g.K, nt = K / BK;
    unsigned voffA[2], voffB[2];
#pragma unroll
    for (int i = 0; i < 2; ++i) { int R, C; stage_rc(tid * 16 + i * 8192, R, C); const int Rb = Epi::PERM ? ((R & ~31) + perm32(R & 31)) : R;
        voffA[i] = g.atile ? (unsigned)(((R >> 4) * (K >> 5) + (C >> 5)) * 1024 + ((R & 15) * 4 + ((C & 31) >> 3)) * 16) : (unsigned)(R * K + C) * 2u;
        voffB[i] = (unsigned)(Rb * K + C) * 2u; }
    const size_t kstep = (size_t)(BK * 2);
    const size_t hstep = (size_t)HALF * K * 2;
    const size_t tstep = 2 * hstep;
    const size_t kstepA = g.atile ? (size_t)2048 : kstep, hstepA = g.atile ? (size_t)8 * (K >> 5) * 1024 : hstep, tstepA = 2 * hstepA;
    const unsigned ldsw = (unsigned)wid * 1024u;
    const int aoff = lds_byte(wr * 64 + fr, fq * 8), boff = lds_byte(wc * 32 + fr, fq * 8);
#define PG8_SA(b, h) (((b) * 2 + (h)) * HTB)
#define PG8_SB(b, h) ((4 + (b) * 2 + (h)) * HTB)
#define PG8_STAGE(bufoff, gbase, voff) do { _Pragma("unroll") for (int _i = 0; _i < 2; ++_i) \
        __builtin_amdgcn_global_load_lds((const unsigned*)((const char*)(gbase) + (voff)[_i]), (PG8_LAS unsigned*)(lds + (bufoff) + ldsw + _i * 8192), 16, 0, 0); } while (0)
#define PG8_LDA(dst, b, h) do { _Pragma("unroll") for (int m = 0; m < 4; ++m) _Pragma("unroll") for (int k = 0; k < 2; ++k) dst[m][k] = *(const PG8_LAS bf16x8*)(lds + PG8_SA(b, h) + aoff + m * 2048 + k * 1024); } while (0)
#define PG8_LDB(dst, b, h) do { _Pragma("unroll") for (int n = 0; n < 2; ++n) _Pragma("unroll") for (int k = 0; k < 2; ++k) dst[n][k] = *(const PG8_LAS bf16x8*)(lds + PG8_SB(b, h) + boff + n * 2048 + k * 1024); } while (0)
#define PG8_MMA(ai, bj, At, Bt) do { __builtin_amdgcn_s_setprio(1); _Pragma("unroll") for (int m = 0; m < 4; ++m) _Pragma("unroll") for (int n = 0; n < 2; ++n) _Pragma("unroll") for (int k = 0; k < 2; ++k) \
        acc[ai][bj][m][n] = __builtin_amdgcn_mfma_f32_16x16x32_bf16(Bt[n][k], At[m][k], acc[ai][bj][m][n], 0, 0, 0); __builtin_amdgcn_s_setprio(0); } while (0)
#define PG8_WAIT_V(n) asm volatile("s_waitcnt vmcnt(" #n ")" ::: "memory")
#define PG8_WAIT_V_UNLESS(n, flag) asm volatile("s_cmp_lg_u32 %0, 0\n\ts_cbranch_scc1 .Lpg8skip%=\n\ts_waitcnt vmcnt(" #n ")\n.Lpg8skip%=:" :: "s"(flag) : "memory", "scc")
#define PG8_WAIT_L(n) asm volatile("s_waitcnt lgkmcnt(" #n ")" ::: "memory")
#define PG8_BAR __builtin_amdgcn_s_barrier()
#define PG8_SCHED __builtin_amdgcn_sched_barrier(0)
    Unit cur, nxt; int ui = 0;
    if (!S.next(0, cur)) return;
    f32x4 acc[2][2][4][2];
#pragma unroll
    for (int a = 0; a < 2; ++a)
#pragma unroll
        for (int b = 0; b < 2; ++b)
#pragma unroll
            for (int m = 0; m < 4; ++m)
#pragma unroll
                for (int n = 0; n < 2; ++n) acc[a][b][m][n] = (f32x4){0.f, 0.f, 0.f, 0.f};
    bf16x8 At[4][2], B0[2][2], B1[2][2];
    const char* cA = (const char*)g.A + (size_t)cur.pm * tstepA; const char* cB = (const char*)g.Bt + (size_t)cur.pn * tstep;
    S.a_ready(cur);
    if constexpr (SP2) {
        PG8_STAGE(PG8_SB(0, 0), cB, voffB); PG8_STAGE(PG8_SB(0, 1), cB + hstep, voffB); PG8_STAGE(PG8_SA(0, 0), cA, voffA); PG8_STAGE(PG8_SA(0, 1), cA + hstepA, voffA);
        if (wr == 1) PG8_BAR;
        PG8_WAIT_V(2); PG8_BAR;
        PG8_STAGE(PG8_SB(1, 0), cB + kstep, voffB); PG8_STAGE(PG8_SA(1, 0), cA + kstepA, voffA); PG8_STAGE(PG8_SB(1, 1), cB + hstep + kstep, voffB);
        PG8_WAIT_V(6); PG8_BAR;
    } else {
        PG8_STAGE(PG8_SB(0, 0), cB, voffB); PG8_STAGE(PG8_SA(0, 0), cA, voffA); PG8_STAGE(PG8_SB(0, 1), cB + hstep, voffB); PG8_STAGE(PG8_SA(0, 1), cA + hstepA, voffA);
        if (wr == 1) PG8_BAR;
        PG8_WAIT_V(4); PG8_BAR;
        PG8_STAGE(PG8_SB(1, 0), cB + kstep, voffB); PG8_STAGE(PG8_SA(1, 0), cA + kstepA, voffA); PG8_STAGE(PG8_SB(1, 1), cB + hstep + kstep, voffB);
        PG8_WAIT_V(6); PG8_BAR;
    }
    for (;;) {
        const bool has_next = S.next(ui + 1, nxt);
        const char* nA = has_next ? (const char*)g.A + (size_t)nxt.pm * tstepA : cA; const char* nB = has_next ? (const char*)g.Bt + (size_t)nxt.pn * tstep : cB;
        for (int t = 0; t < nt; t += 2) {
            if constexpr (Epi::MID) { if (t == Epi::MID_T) E.mid(acc, cur, wr, fr); }
            const bool last = (t == nt - 2);
            const char* a1 = cA + (size_t)(t + 1) * kstepA;
            const char* a2 = last ? nA : cA + (size_t)(t + 2) * kstepA; const char* b2 = last ? nB : cB + (size_t)(t + 2) * kstep;
            const char* a3 = a2 + kstepA; const char* b3 = b2 + kstep;
            if (last && has_next) S.a_ready(nxt);
            const int skipw = __builtin_amdgcn_readfirstlane((Epi::SPLIT && t == 0 && ui > 0) ? 1 : 0);
            if constexpr (SP2) {
            PG8_LDB(B0, 0, 0); PG8_LDB(B1, 0, 1); PG8_SCHED; PG8_LDA(At, 0, 0); PG8_STAGE(PG8_SA(1, 1), a1 + hstepA, voffA);
            PG8_WAIT_V_UNLESS(8, skipw); PG8_WAIT_L(0); PG8_BAR; PG8_MMA(0, 0, At, B0); PG8_MMA(0, 1, At, B1); PG8_BAR; PG8_SCHED;
            PG8_LDA(At, 0, 1); PG8_STAGE(PG8_SB(0, 0), b2, voffB); PG8_STAGE(PG8_SB(0, 1), b2 + hstep, voffB); PG8_STAGE(PG8_SA(0, 0), a2, voffA);
            PG8_WAIT_V_UNLESS(8, skipw); PG8_WAIT_L(0); PG8_BAR; PG8_MMA(1, 0, At, B0); PG8_MMA(1, 1, At, B1); PG8_BAR; PG8_SCHED;
            PG8_LDB(B0, 1, 0); PG8_LDB(B1, 1, 1); PG8_SCHED; PG8_LDA(At, 1, 0); PG8_STAGE(PG8_SA(0, 1), a2 + hstepA, voffA);
            PG8_WAIT_V(8); PG8_WAIT_L(0); PG8_BAR; PG8_MMA(0, 0, At, B0); PG8_MMA(0, 1, At, B1); PG8_BAR; PG8_SCHED;
            PG8_LDA(At, 1, 1); PG8_STAGE(PG8_SB(1, 0), b3, voffB); PG8_STAGE(PG8_SB(1, 1), b3 + hstep, voffB); PG8_STAGE(PG8_SA(1, 0), a3, voffA);
            PG8_WAIT_V(8); PG8_WAIT_L(0); PG8_BAR; PG8_MMA(1, 0, At, B0); PG8_MMA(1, 1, At, B1); PG8_BAR; PG8_SCHED;
            } else {
            PG8_LDB(B0, 0, 0); PG8_SCHED; PG8_LDA(At, 0, 0); PG8_STAGE(PG8_SA(1, 1), a1 + hstepA, voffA);
            PG8_WAIT_L(8); PG8_BAR; PG8_WAIT_L(0); PG8_MMA(0, 0, At, B0); PG8_BAR; PG8_SCHED;
            PG8_LDB(B1, 0, 1); PG8_STAGE(PG8_SB(0, 0), b2, voffB);
            PG8_BAR; PG8_WAIT_L(0); PG8_MMA(0, 1, At, B1); PG8_BAR;
            PG8_LDA(At, 0, 1); PG8_STAGE(PG8_SA(0, 0), a2, voffA);
            PG8_BAR; PG8_WAIT_L(0); PG8_MMA(1, 0, At, B0); PG8_BAR; PG8_SCHED;
            PG8_STAGE(PG8_SB(0, 1), b2 + hstep, voffB);
            PG8_WAIT_V(6); PG8_BAR; PG8_MMA(1, 1, At, B1); PG8_BAR;
            PG8_LDB(B0, 1, 0); PG8_SCHED; PG8_LDA(At, 1, 0); PG8_STAGE(PG8_SA(0, 1), a2 + hstepA, voffA);
            PG8_WAIT_L(8); PG8_BAR; PG8_WAIT_L(0); PG8_MMA(0, 0, At, B0); PG8_BAR; PG8_SCHED;
            PG8_LDB(B1, 1, 1); PG8_STAGE(PG8_SB(1, 0), b3, voffB);
            PG8_BAR; PG8_WAIT_L(0); PG8_MMA(0, 1, At, B1); PG8_BAR;
            PG8_LDA(At, 1, 1); PG8_STAGE(PG8_SA(1, 0), a3, voffA);
            PG8_BAR; PG8_WAIT_L(0); PG8_MMA(1, 0, At, B0); PG8_BAR; PG8_SCHED;
            PG8_STAGE(PG8_SB(1, 1), b3 + hstep, voffB);
            PG8_WAIT_V(6); PG8_BAR; PG8_MMA(1, 1, At, B1); PG8_BAR;
            }
        }
        if constexpr (ALIGN_EPI) { if (wr == 0) PG8_BAR; }
        if constexpr (Epi::SPLIT) PG8_WAIT_V(0);
        if constexpr (!Epi::AFTER_DRAIN) { if constexpr (Epi::FUSEDN) { static_assert(ALIGN_EPI, "the fused-norm epilogue has workgroup barriers: both halves must reach it together"); E.fusedn(acc, cur, wr, wc, fr, fq, lds, wid, lane); } else E(acc, cur, wr, wc, fr, fq); S.done(cur); }
        if (!has_next) break;
#pragma unroll
        for (int a = 0; a < 2; ++a)
#pragma unroll
            for (int b = 0; b < 2; ++b)
#pragma unroll
                for (int m = 0; m < 4; ++m)
#pragma unroll
                    for (int n = 0; n < 2; ++n) acc[a][b][m][n] = (f32x4){0.f, 0.f, 0.f, 0.f};
        cur = nxt; cA = nA; cB = nB; ++ui;
        if constexpr (ALIGN_EPI) { if (wr == 1) PG8_BAR; }
    }
    PG8_WAIT_V(0);
    if constexpr (!ALIGN_EPI) { if (wr == 0) PG8_BAR; }
    PG8_BAR;
    if constexpr (Epi::AFTER_DRAIN) { E.fused(acc, cur, wr, wc, fr, fq, lds, wid, lane); S.done(cur); }
#undef PG8_SA
#undef PG8_SB
#undef PG8_STAGE
#undef PG8_LDA
#undef PG8_LDB
#undef PG8_MMA
#undef PG8_WAIT_V
#undef PG8_WAIT_V_UNLESS
#undef PG8_WAIT_L
#undef PG8_BAR
#undef PG8_SCHED
}
}
#include <hip/hip_bf16.h>
#include <cmath>
namespace attn_body {
using bf16=__hip_bfloat16;
using bf16x8=__attribute__((ext_vector_type(8)))short;
using s16x4=__attribute__((ext_vector_type(4)))short;
using f32x16=__attribute__((ext_vector_type(16)))float;
using u32x4=__attribute__((ext_vector_type(4)))unsigned;
constexpr int BATCH=32,NHEAD=8,SEQ=2048,D=64,DM=512,OPITCH=1024;
constexpr int NW=8,QBLK=32,QB=QBLK*NW,KVBLK=64,NQB=SEQ/QB;
constexpr int ATTN_PITCH=DM, ATTN_UNIT_ROWS=QB;
__device__ __forceinline__ int crow(int r,int hi){return (r&3)+8*(r>>2)+4*hi;}
#define SBAR() __builtin_amdgcn_sched_barrier(0)
__device__ __forceinline__ void cmask(f32x16&p0,f32x16&p1,int jb,int qrel,int hi){
  const float NEG=-INFINITY; int kb=64*jb+4*hi;
  #pragma unroll
  for(int r=0;r<16;++r){int kv=kb+(r&3)+8*(r>>2); if(kv>qrel)p0[r]=NEG; if(kv+32>qrel)p1[r]=NEG;}
}

constexpr int NSLOT=3, SLOTB=8192;
constexpr int LDS_K=0, LDS_V=NSLOT*SLOTB, LDS_WS=2*NSLOT*SLOTB, LDS_OST=LDS_WS+NW*64*4, LDS_KA=LDS_OST+NW*4096,LDS_BYTES=LDS_KA+SEQ*16;
constexpr float C2=0.125f*1.4426950408889634f;
__device__ __forceinline__ void glds16(const void*gsrc,unsigned lds_dst){unsigned keep;
  asm volatile("s_mov_b32 %0, m0\n\ts_mov_b32 m0, %2\n\ts_nop 0\n\tglobal_load_lds_dwordx4 %1, off\n\ts_mov_b32 m0, %0":"=&s"(keep):"v"(gsrc),"s"(lds_dst):"memory");}
__device__ __forceinline__ float max3f(float a,float b,float c){float r;asm("v_max3_f32 %0, %1, %2, %3":"=v"(r):"v"(a),"v"(b),"v"(c));return r;}
__device__ __forceinline__ float max2f(float a,float b){float r;asm("v_max_f32_e32 %0, %1, %2":"=v"(r):"v"(a),"v"(b));return r;}
__device__ __forceinline__ float fadd_s(float a,float b){float r;asm("v_add_f32_e32 %0, %1, %2":"=v"(r):"v"(a),"v"(b));return r;}
__device__ __forceinline__ float fsub_s(float a,float b){float r;asm("v_sub_f32_e32 %0, %1, %2":"=v"(r):"v"(a),"v"(b));return r;}
typedef float f32x2_t __attribute__((ext_vector_type(2))); typedef __bf16 bf16x2_t __attribute__((ext_vector_type(2)));
__device__ __forceinline__ unsigned cvtpk_s(float lo,float hi){f32x2_t v={lo,hi};bf16x2_t b=__builtin_convertvector(v,bf16x2_t);return __builtin_bit_cast(unsigned,b);}
#define WAIT_BAR(N) asm volatile("s_waitcnt vmcnt(" #N ") lgkmcnt(0)\n\ts_barrier":::"memory")

__device__ __forceinline__ void qkt(f32x16&p0,f32x16&p1,const char*Kslot,const bf16x8*qr,const f32x16&negm,int r32,int hi,const bf16x8&ka0,const bf16x8&ka1,const bf16x8&qa){
  const char*kb=Kslot+hi*1024+r32*16;
  #pragma unroll
  for(int d0=0;d0<4;++d0){
    const bf16x8 b0=*reinterpret_cast<const bf16x8*>(kb+d0*2048);
    const bf16x8 b1=*reinterpret_cast<const bf16x8*>(kb+d0*2048+512);
    if(d0==0){p0=__builtin_amdgcn_mfma_f32_32x32x16_bf16(b0,qr[0],negm,0,0,0);p1=__builtin_amdgcn_mfma_f32_32x32x16_bf16(b1,qr[0],negm,0,0,0);}
    else{p0=__builtin_amdgcn_mfma_f32_32x32x16_bf16(b0,qr[d0],p0,0,0,0);p1=__builtin_amdgcn_mfma_f32_32x32x16_bf16(b1,qr[d0],p1,0,0,0);}}
  p0=__builtin_amdgcn_mfma_f32_32x32x16_bf16(ka0,qa,p0,0,0,0);p1=__builtin_amdgcn_mfma_f32_32x32x16_bf16(ka1,qa,p1,0,0,0);
}
typedef __attribute__((address_space(3))) const char* lds_cptr;
typedef short v4i16_t __attribute__((ext_vector_type(4)));
__device__ __forceinline__ void kload8(bf16x8*kf,lds_cptr kp){
  kf[0]=*(const __attribute__((address_space(3))) bf16x8*)(kp);      kf[1]=*(const __attribute__((address_space(3))) bf16x8*)(kp+512);
  kf[2]=*(const __attribute__((address_space(3))) bf16x8*)(kp+2048); kf[3]=*(const __attribute__((address_space(3))) bf16x8*)(kp+2560);
  kf[4]=*(const __attribute__((address_space(3))) bf16x8*)(kp+4096); kf[5]=*(const __attribute__((address_space(3))) bf16x8*)(kp+4608);
  kf[6]=*(const __attribute__((address_space(3))) bf16x8*)(kp+6144); kf[7]=*(const __attribute__((address_space(3))) bf16x8*)(kp+6656);
}
__device__ __forceinline__ void kload2(bf16x8*kf,lds_cptr kp,int j){ kf[2*j]=*(const __attribute__((address_space(3))) bf16x8*)(kp+j*2048); kf[2*j+1]=*(const __attribute__((address_space(3))) bf16x8*)(kp+j*2048+512); }
__device__ __forceinline__ s16x4 vtr(lds_cptr p){ return __builtin_bit_cast(s16x4,__builtin_amdgcn_ds_read_tr16_b64_v4i16((__attribute__((address_space(3))) v4i16_t*)p)); }
__device__ __forceinline__ float rowmax(const f32x16&p0,const f32x16&p1){
  float a=max3f(p0[0],p0[1],p1[0]),b=max3f(p0[2],p0[3],p1[1]);a=max3f(a,p1[2],p1[3]);
  #pragma unroll
  for(int r=4;r<16;r+=4){a=max3f(a,p0[r],p0[r+1]);b=max3f(b,p0[r+2],p0[r+3]);a=max3f(a,p1[r],p1[r+1]);b=max3f(b,p1[r+2],p1[r+3]);}
  const float m=max2f(a,b);
  auto rr=__builtin_amdgcn_permlane32_swap(__float_as_uint(m),__float_as_uint(m),false,false);
  return max2f(__uint_as_float(rr[0]),__uint_as_float(rr[1]));
}
__device__ __forceinline__ void pv(f32x16*o,int vb,bf16x8 pa0,bf16x8 pa1,bf16x8 pa2,bf16x8 pa3){
  #pragma unroll
  for(int d0=0;d0<2;++d0){s16x4 lo[4],hi[4];
    #pragma unroll
    for(int ks=0;ks<4;++ks){
      asm volatile("ds_read_b64_tr_b16 %0,%1 offset:%c2":"=&v"(lo[ks]):"v"(vb),"i"(d0*4096+ks*1024):"memory");
      asm volatile("ds_read_b64_tr_b16 %0,%1 offset:%c2":"=&v"(hi[ks]):"v"(vb),"i"(d0*4096+ks*1024+512):"memory");}
    asm volatile("s_waitcnt lgkmcnt(0)":::"memory");SBAR();
    #define PK(k) (bf16x8){lo[k][0],lo[k][1],lo[k][2],lo[k][3],hi[k][0],hi[k][1],hi[k][2],hi[k][3]}
    o[d0]=__builtin_amdgcn_mfma_f32_32x32x16_bf16(pa0,PK(0),o[d0],0,0,0);
    o[d0]=__builtin_amdgcn_mfma_f32_32x32x16_bf16(pa1,PK(1),o[d0],0,0,0);
    o[d0]=__builtin_amdgcn_mfma_f32_32x32x16_bf16(pa2,PK(2),o[d0],0,0,0);
    o[d0]=__builtin_amdgcn_mfma_f32_32x32x16_bf16(pa3,PK(3),o[d0],0,0,0);
    #undef PK
  }
}

#ifndef ATTN_STORE16
#define ATTN_STORE16(p,v) (*(u32x4*)(p)=(v))
#endif
template<int THRL,bool COPYF> __device__ __forceinline__ void attn_unit(int b,int h,int qb,const bf16*Q,const bf16*__restrict__ K,const bf16*__restrict__ V,bf16*O,const float*__restrict__ Fg,float*__restrict__ ssq,char*shm){
  int tid_=threadIdx.x; asm volatile("":"+v"(tid_)); const int tid=tid_,lane=tid&63,r32=lane&31,hi=lane>>5; const int wid=__builtin_amdgcn_readfirstlane(tid>>6);
  const long rowbase=(long)b*SEQ; const int q0=qb*QB;
  const bf16*Qw=Q+(rowbase+q0+wid*QBLK)*DM+h*D;
  const bf16*Kh=K+rowbase*DM+h*D,*Vh=V+rowbase*DM+h*D;
  const lds_cptr shm3=(lds_cptr)shm;
  const unsigned lds0=(unsigned)(uintptr_t)shm;
  float*wsf=(float*)(shm+LDS_WS)+wid*64;
  const bf16*ksrc=Kh+(long)lane*DM+wid*8;
  const bf16*vsrc=Vh+(long)(16*(wid&3)+(lane>>2))*DM+(wid>>2)*32+(lane&3)*8;
  const unsigned kdst=lds0+LDS_K+wid*1024, vdst=lds0+LDS_V+wid*1024;
  #define DMA_K(t,slot) glds16(ksrc+(long)(t)*KVBLK*DM,(unsigned)__builtin_amdgcn_readfirstlane(kdst+(slot)))
  #define DMA_V(t,slot) glds16(vsrc+(long)(t)*KVBLK*DM,(unsigned)__builtin_amdgcn_readfirstlane(vdst+(slot)))
  const int vb0=(int)(lds0+LDS_V)+((lane>>4)&1)*32+(lane&3)*8+(4*hi+((lane&15)>>2))*64;
  const char*Kbase=shm+LDS_K; bf16x8 kf[8];
  const lds_cptr kp0=shm3+LDS_K+hi*1024+r32*16; const lds_cptr vp0=shm3+LDS_V+((lane>>4)&1)*32+(lane&3)*8+(4*hi+((lane&15)>>2))*64;
  const int NT=(q0+QB)/KVBLK;
  typedef float f32x4_t __attribute__((ext_vector_type(4))); typedef __attribute__((address_space(3))) u32x4 lds_u4; typedef __attribute__((address_space(3))) const bf16x8 lds_cfrag;
  f32x4_t fv_=f32x4_t{}; const bool docp_=COPYF&&(tid*4<q0+QB); if(docp_)fv_=*reinterpret_cast<const f32x4_t*>(Fg+tid*4);
  const float gq_=Fg[q0+wid*QBLK+r32];
  DMA_K(0,0);DMA_V(0,0);DMA_K(1,SLOTB);
  bf16x8 qr[4];
  #pragma unroll
  for(int d0=0;d0<4;++d0)qr[d0]=*reinterpret_cast<const bf16x8*>(&Qw[(long)r32*DM+d0*16+hi*8]);
  float mhat=0.f,l_reg=0.f;f32x16 o[2];o[0]=f32x16{};o[1]=f32x16{};f32x16 negm=f32x16{};asm volatile("":"+v"(negm));
  const int qrel=wid*QBLK+r32;
  #define CMASK(P0,P1,t) do{int jb_=(t)-(NT-4); if(jb_>=0)cmask(P0,P1,jb_,qrel,hi);}while(0)
  bool resc=false;
  #define START(P0,P1) do{ const float rm=rowmax(P0,P1); resc=false; \
    { const float dl=rm; mhat=fadd_s(mhat,dl); \
      _Pragma("unroll") for(int r=0;r<16;++r){P0[r]=fsub_s(P0[r],dl);P1[r]=fsub_s(P1[r],dl);} \
      _Pragma("unroll") for(int r=0;r<16;++r)negm[r]=-mhat; asm volatile("":"+v"(negm)); } \
    _Pragma("unroll") for(int r=0;r<16;++r)P0[r]=__builtin_amdgcn_exp2f(P0[r]); }while(0)
  #define RESC() do{ if(resc){ asm volatile("s_waitcnt lgkmcnt(0)":::"memory"); \
      _Pragma("unroll") for(int d_=0;d_<2;++d_) _Pragma("unroll") for(int r=0;r<16;++r)o[d_][r]*=wsf[crow(r,hi)]; } }while(0)
  f32x16 pA0,pA1,pB0,pB1;
  int sl_prev=0,sl_cur=0,sl_next=SLOTB;
  #define ROT() do{sl_prev=sl_cur;sl_cur=sl_next;sl_next=(sl_next==(NSLOT-1)*SLOTB)?0:sl_next+SLOTB;}while(0)
  DMA_K(2,2*SLOTB);
  #define SPLIT3(x,H,M,L) do{ const unsigned h_=cvtpk_s((x),0.f)&0xffffu; const float r1_=(x)-__uint_as_float(h_<<16); const unsigned m_=cvtpk_s(r1_,0.f)&0xffffu; const float r2_=r1_-__uint_as_float(m_<<16); H=h_; M=m_; L=cvtpk_s(r2_,0.f)&0xffffu; }while(0)
  if(docp_){ _Pragma("unroll") for(int e_=0;e_<4;++e_){ unsigned fh_,fm_,fl_; const float f_=-fv_[e_]; SPLIT3(f_,fh_,fm_,fl_);
      *(lds_u4*)(shm3+LDS_KA+(tid*4+e_)*16)=(u32x4){fh_|(fm_<<16),fl_|0x3f800000u,0x3f803f80u,0u}; } }
  bf16x8 qa; { unsigned gh_,gm_,gl_; SPLIT3(gq_,gh_,gm_,gl_); const u32x4 w_=hi?(u32x4){0u,0u,0u,0u}:(u32x4){0x3f803f80u,0x3f80u|(gh_<<16),gm_|(gl_<<16),0u}; qa=__builtin_bit_cast(bf16x8,w_); }
  #undef SPLIT3
  const lds_cptr kap=shm3+LDS_KA+r32*16;
  WAIT_BAR(3);
  { const bf16x8 ka0s_=*(lds_cfrag*)(kap), ka1s_=*(lds_cfrag*)(kap+512); qkt(pA0,pA1,Kbase,qr,negm,r32,hi,ka0s_,ka1s_,qa); }asm volatile("s_nop 15\n\ts_nop 7":"+v"(pA0),"+v"(pA1));CMASK(pA0,pA1,0);
  START(pA0,pA1);
  _Pragma("unroll") for(int r=0;r<16;++r)pA1[r]=__builtin_amdgcn_exp2f(pA1[r]);
  WAIT_BAR(0);
  DMA_K(3,0);DMA_V(1,SLOTB);
  ROT();
  kload8(kf,kp0+sl_cur);
  WAIT_BAR(2);
  s16x4 vlo[8],vhi[8]; u32x4 pw0,pw1,pw2,pw3;
  #define PKW(P,B) cvtpk_s(P[B],P[B+1])
  #define PAF(k) __builtin_bit_cast(bf16x8,pw##k)
  #define VFR(i) (bf16x8){vlo[i][0],vlo[i][1],vlo[i][2],vlo[i][3],vhi[i][0],vhi[i][1],vhi[i][2],vhi[i][3]}
  #define PIN(x) asm volatile("":"+v"(x))
  #define MX3(a,b,c) __builtin_fmaxf(__builtin_fmaxf((a),(b)),(c))
  #define GAPA(MF,A0,A1,A2,A3,W0,W1,PW) do{ MF; sacc+=A0; sacc+=A1; sacc+=A2; sacc+=A3; PIN(sacc); W0; W1; PIN(PW); SBAR(); }while(0)
  #define EX(v) __builtin_amdgcn_exp2f(v)
  #define GAPB(MF,X,B) do{ MF; X[B]=EX(X[B]); X[B+1]=EX(X[B+1]); X[B+2]=EX(X[B+2]); X[B+3]=EX(X[B+3]); PIN(X); SBAR(); }while(0)
  #define VRD(i) do{ vlo[i]=vtr(vp_+(((i)>>2)*4096+((i)&3)*1024)); vhi[i]=vtr(vp_+(((i)>>2)*4096+((i)&3)*1024+512)); }while(0)
  #define KRD(G,j) do{ if(G){ kload2(kf,kp0+sl_next,j); SBAR(); } }while(0)
  #define STEP(C0,C1,P0,P1,t,GK,GV,GL) do{ SBAR(); \
    const lds_cptr vp_=vp0+sl_prev; const bf16x8 ka0_=*(lds_cfrag*)(kap+(t)*1024), ka1_=*(lds_cfrag*)(kap+(t)*1024+512); \
    VRD(0); SBAR(); float sacc=(P0[0]+P0[1]); \
    GAPA(C0=__builtin_amdgcn_mfma_f32_32x32x16_bf16(kf[0],qr[0],negm,0,0,0), P0[2],P0[3],P0[4],P0[5],     pw0[0]=PKW(P0,0), pw0[1]=PKW(P0,2), pw0); \
    VRD(4); SBAR(); GAPA(C1=__builtin_amdgcn_mfma_f32_32x32x16_bf16(kf[1],qr[0],negm,0,0,0), P0[6],P0[7],P0[8],P0[9],     pw0[2]=PKW(P0,4), pw0[3]=PKW(P0,6), pw0); \
    VRD(1); SBAR(); GAPA(C0=__builtin_amdgcn_mfma_f32_32x32x16_bf16(kf[2],qr[1],C0,0,0,0),   P0[10],P0[11],P0[12],P0[13], pw1[0]=PKW(P0,8), pw1[1]=PKW(P0,10), pw1); \
    VRD(5); SBAR(); GAPA(C1=__builtin_amdgcn_mfma_f32_32x32x16_bf16(kf[3],qr[1],C1,0,0,0),   P0[14],P0[15],P1[0],P1[1],   pw1[2]=PKW(P0,12),pw1[3]=PKW(P0,14), pw1); \
    VRD(2); SBAR(); GAPA(C0=__builtin_amdgcn_mfma_f32_32x32x16_bf16(kf[4],qr[2],C0,0,0,0),   P1[2],P1[3],P1[4],P1[5],     pw2[0]=PKW(P1,0), pw2[1]=PKW(P1,2), pw2); \
    VRD(6); SBAR(); GAPA(C1=__builtin_amdgcn_mfma_f32_32x32x16_bf16(kf[5],qr[2],C1,0,0,0),   P1[6],P1[7],P1[8],P1[9],     pw2[2]=PKW(P1,4), pw2[3]=PKW(P1,6), pw2); \
    VRD(3); SBAR(); GAPA(C0=__builtin_amdgcn_mfma_f32_32x32x16_bf16(kf[6],qr[3],C0,0,0,0),   P1[10],P1[11],P1[12],P1[13], pw3[0]=PKW(P1,8), pw3[1]=PKW(P1,10), pw3); \
    VRD(7); SBAR(); GAPA(C1=__builtin_amdgcn_mfma_f32_32x32x16_bf16(kf[7],qr[3],C1,0,0,0),   P1[14],P1[15],0.f,0.f,       pw3[2]=PKW(P1,12),pw3[3]=PKW(P1,14), pw3); \
    C0=__builtin_amdgcn_mfma_f32_32x32x16_bf16(ka0_,qa,C0,0,0,0); C1=__builtin_amdgcn_mfma_f32_32x32x16_bf16(ka1_,qa,C1,0,0,0); SBAR(); \
    l_reg+=sacc; \
    if(GK){DMA_K((t)+3,sl_cur);} if(GV){DMA_V((t)+1,sl_next);} \
    CMASK(C0,C1,t); \
    { float a=MX3(C0[0],C0[1],C1[0]),b=MX3(C0[2],C0[3],C1[1]); a=MX3(a,C1[2],C1[3]); \
      _Pragma("unroll") for(int r=4;r<16;r+=4){a=MX3(a,C0[r],C0[r+1]);b=MX3(b,C0[r+2],C0[r+3]);a=MX3(a,C1[r],C1[r+1]);b=MX3(b,C1[r+2],C1[r+3]);} \
      float rm=__builtin_fmaxf(a,b); { auto rr=__builtin_amdgcn_permlane32_swap(__float_as_uint(rm),__float_as_uint(rm),false,false); rm=__builtin_fmaxf(__uint_as_float(rr[0]),__uint_as_float(rr[1])); } \
      resc=false; \
      if(__builtin_expect(__any(rm>(float)THRL),0)){ const float dl=__builtin_fmaxf(rm,0.f); mhat+=dl; \
        _Pragma("unroll") for(int r=0;r<16;++r){C0[r]-=dl;C1[r]-=dl;} \
        _Pragma("unroll") for(int r=0;r<16;++r)negm[r]=-mhat; asm volatile("":"+v"(negm)); \
        const float f=__builtin_amdgcn_exp2f(-dl); l_reg*=f; if(hi==0)wsf[r32]=f; resc=true; } } \
    SBAR(); \
    GAPB(o[0]=__builtin_amdgcn_mfma_f32_32x32x16_bf16(PAF(0),VFR(0),o[0],0,0,0), C0,0); \
    GAPB(o[1]=__builtin_amdgcn_mfma_f32_32x32x16_bf16(PAF(0),VFR(4),o[1],0,0,0), C0,4); \
    KRD(GL,0); GAPB(o[0]=__builtin_amdgcn_mfma_f32_32x32x16_bf16(PAF(1),VFR(1),o[0],0,0,0), C0,8); \
    KRD(GL,1); GAPB(o[1]=__builtin_amdgcn_mfma_f32_32x32x16_bf16(PAF(1),VFR(5),o[1],0,0,0), C0,12); \
    KRD(GL,2); GAPB(o[0]=__builtin_amdgcn_mfma_f32_32x32x16_bf16(PAF(2),VFR(2),o[0],0,0,0), C1,0); \
    KRD(GL,3); GAPB(o[1]=__builtin_amdgcn_mfma_f32_32x32x16_bf16(PAF(2),VFR(6),o[1],0,0,0), C1,4); \
    GAPB(o[0]=__builtin_amdgcn_mfma_f32_32x32x16_bf16(PAF(3),VFR(3),o[0],0,0,0), C1,8); \
    GAPB(o[1]=__builtin_amdgcn_mfma_f32_32x32x16_bf16(PAF(3),VFR(7),o[1],0,0,0), C1,12); \
    }while(0)
  int t=1;
  #undef CMASK
  #define CMASK(P0,P1,t) do{}while(0)
  for(;t+5<NT;t+=2){
    STEP(pB0,pB1,pA0,pA1,t,true,true,true);     WAIT_BAR(2); RESC(); ROT();
    STEP(pA0,pA1,pB0,pB1,t+1,true,true,true);   WAIT_BAR(2); RESC(); ROT();
  }
  #undef CMASK
  #define CMASK(P0,P1,t) do{int jb_=(t)-(NT-4); if(jb_>=0)cmask(P0,P1,jb_,qrel,hi);}while(0)
  #define ENDW(tt) do{ if((tt)+3<NT){WAIT_BAR(2);} else if((tt)+2<NT){WAIT_BAR(1);} else {WAIT_BAR(0);} }while(0)
  for(;t+1<NT;t+=2){
    STEP(pB0,pB1,pA0,pA1,t,(t+3<NT),(t+1<NT),(t+1<NT));       ENDW(t);   RESC(); ROT();
    STEP(pA0,pA1,pB0,pB1,t+1,(t+4<NT),(t+2<NT),(t+2<NT));     ENDW(t+1); RESC(); ROT();
  }
  STEP(pB0,pB1,pA0,pA1,NT-1,false,false,false); RESC();
  { float sacc=pB0[0]+pB0[1]; _Pragma("unroll") for(int r=2;r<16;++r)sacc+=pB0[r]; _Pragma("unroll") for(int r=0;r<16;++r)sacc+=pB1[r]; l_reg+=sacc;
    pw0=(u32x4){PKW(pB0,0),PKW(pB0,2),PKW(pB0,4),PKW(pB0,6)};pw1=(u32x4){PKW(pB0,8),PKW(pB0,10),PKW(pB0,12),PKW(pB0,14)};pw2=(u32x4){PKW(pB1,0),PKW(pB1,2),PKW(pB1,4),PKW(pB1,6)};pw3=(u32x4){PKW(pB1,8),PKW(pB1,10),PKW(pB1,12),PKW(pB1,14)};
    SBAR(); pv(o,vb0+sl_cur,PAF(0),PAF(1),PAF(2),PAF(3)); }
  #undef PKW
  #undef PAF
  #undef VFR
  #undef PIN
  #undef MX3
  #undef GAPA
  #undef GAPB
  #undef EX
  #undef VRD
  #undef KRD
  #undef STEP
  #undef ENDW
  {auto rr=__builtin_amdgcn_permlane32_swap(__float_as_uint(l_reg),__float_as_uint(l_reg),false,false);l_reg=__uint_as_float(rr[0])+__uint_as_float(rr[1]);}
  if(hi==0)wsf[32+r32]=l_reg;asm volatile("s_waitcnt lgkmcnt(0)":::"memory");
  float rli[16];
  #pragma unroll
  for(int r=0;r<16;++r)rli[r]=__builtin_amdgcn_rcpf(wsf[32+crow(r,hi)]);
  bf16*Ow=O+(rowbase+q0+wid*QBLK)*OPITCH+h*D; float*sq=ssq+(rowbase+q0+wid*QBLK)*NHEAD+h;
  { bf16*stg=(bf16*)(shm+LDS_OST)+wid*2048;
    #pragma unroll
    for(int r=0;r<16;++r){const int orow=crow(r,hi);
      #pragma unroll
      for(int d0=0;d0<2;++d0)stg[orow*64+d0*32+r32]=__float2bfloat16(o[d0][r]*rli[r]);}
    asm volatile("s_waitcnt lgkmcnt(0)":::"memory");
    #pragma unroll
    for(int i=0;i<4;++i){const int row=i*8+(lane>>3),ch=lane&7; const u32x4 v=*(const u32x4*)(stg+row*64+ch*8); ATTN_STORE16(Ow+(long)row*OPITCH+ch*8,v);
      float s2=0.f; _Pragma("unroll") for(int e=0;e<4;++e){ const float lo_=__uint_as_float(v[e]<<16), hi_=__uint_as_float(v[e]&0xffff0000u); s2+=lo_*lo_+hi_*hi_; }
      s2+=__shfl_xor(s2,1); s2+=__shfl_xor(s2,2); s2+=__shfl_xor(s2,4); if(ch==0)sq[(long)row*NHEAD]=s2; } }
  asm volatile("s_waitcnt lgkmcnt(0)\n\ts_barrier":::"memory");
  #undef DMA_K
  #undef DMA_V
  #undef CMASK
  #undef START
  #undef RESC
  #undef ROT
}
constexpr int ATTN_LDS_BYTES=LDS_BYTES;
#undef SBAR
#undef WAIT_BAR
}
namespace hg {
#define HLAS __attribute__((address_space(3)))
typedef short bf16x8 __attribute__((ext_vector_type(8)));
typedef short v4i16_t __attribute__((ext_vector_type(4)));
typedef float f32x16 __attribute__((ext_vector_type(16)));
typedef float f32x4 __attribute__((ext_vector_type(4)));
typedef unsigned u32x4 __attribute__((ext_vector_type(4)));
typedef float f32x2_t __attribute__((ext_vector_type(2))); typedef __bf16 bf16x2_t __attribute__((ext_vector_type(2)));
typedef unsigned short bf16_t;
__device__ __forceinline__ unsigned cvtpk(float lo, float hi) { f32x2_t v = {lo, hi}; bf16x2_t b = __builtin_convertvector(v, bf16x2_t); return __builtin_bit_cast(unsigned, b); }
__device__ __forceinline__ unsigned off_b(unsigned row, unsigned ch) { return 272u * row + 16u * ch; }
__device__ __forceinline__ int crow(int reg, int h) { return (reg & 3) + 8 * (reg >> 2) + 4 * h; }
__device__ __forceinline__ bf16x8 pack8(const f32x16& x, int s) {
    u32x4 p; p.x = cvtpk(x[8 * s], x[8 * s + 1]); p.y = cvtpk(x[8 * s + 2], x[8 * s + 3]); p.z = cvtpk(x[8 * s + 4], x[8 * s + 5]); p.w = cvtpk(x[8 * s + 6], x[8 * s + 7]);
    return __builtin_bit_cast(bf16x8, p);
}
__device__ __forceinline__ v4i16_t trd(HLAS const unsigned char* p) { return __builtin_amdgcn_ds_read_tr16_b64_v4i16((HLAS v4i16_t*)p); }
__device__ __forceinline__ void glds16(const void* gsrc, unsigned lds_dst) { unsigned keep;
    asm volatile("s_mov_b32 %0, m0\n\ts_mov_b32 m0, %2\n\ts_nop 0\n\tglobal_load_lds_dwordx4 %1, off\n\ts_mov_b32 m0, %0" : "=&s"(keep) : "v"(gsrc), "s"(lds_dst) : "memory"); }
__device__ __forceinline__ unsigned off_v(unsigned row, unsigned ch) { return 256u * row + 16u * ch; }
#define HMFMA(a, b, c) __builtin_amdgcn_mfma_f32_32x32x16_bf16((a), (b), (c), 0, 0, 0)
#define HG_BAR() do { asm volatile("s_waitcnt lgkmcnt(0)" ::: "memory"); __builtin_amdgcn_s_barrier(); asm volatile("" ::: "memory"); } while (0)
constexpr int IMG_ONE = 64 * 272, IMG_QT = 0, IMG_QP = IMG_ONE, IMG_KH = 2 * IMG_ONE, IMG_VV = 3 * IMG_ONE, IMG_BYTES = 4 * IMG_ONE, AUX_BYTES = 2560, OB_PITCH = 132;
constexpr int NCH = 32, CH = 64, PITCH = 512, OPITCH = 1024;

__device__ __forceinline__ void hgrn_unit(int unit, const bf16_t* QF, const bf16_t* KK, const bf16_t* VI, const bf16_t* GH, bf16_t* OC, HLAS unsigned char* lds, HLAS unsigned char* aux0) {
    int tid_ = threadIdx.x; asm volatile("" : "+v"(tid_));
    const int tid = tid_, lane = tid & 63, wid = __builtin_amdgcn_readfirstlane(tid >> 6), role = wid >> 2, gw = wid & 3, gt = tid & 255;
    const int bh = unit, b = bh >> 2, h = bh & 3, r32 = lane & 31, hh = lane >> 5;
    const size_t rowbase = (size_t)b * 2048; const int cb = h * 128;
    const int blk = (lane >> 4) & 1, tq = (lane & 15) >> 2, tp = lane & 3;
#define HG_DMA_V(c) do { const bf16_t* vs_ = VI + (rowbase + (size_t)(c) * CH + 16 * gw + (lane >> 4)) * PITCH + cb + 8 * (lane & 15); const unsigned vdst0 = (unsigned)(size_t)(img + IMG_VV) + (unsigned)(16 * gw) * 256u; \
        _Pragma("unroll") for (int j = 0; j < 4; ++j) glds16(vs_ + (size_t)(4 * j) * PITCH, (unsigned)__builtin_amdgcn_readfirstlane(vdst0 + 1024u * j)); } while (0)
#define HG_LOAD_RAW(KD, QD, c) do { const size_t r0_ = rowbase + (size_t)(c) * CH; \
        _Pragma("unroll") for (int i = 0; i < 16; ++i) { const size_t o_ = (r0_ + 16 * gw + i) * PITCH + cb + 2 * lane; KD[i] = *(const unsigned*)(KK + o_); QD[i] = *(const unsigned*)(QF + o_); } \
        } while (0)
    if (role == 0) {
        unsigned kk2[16], qf2[16], kkn[16], qfn[16];
#pragma unroll
        for (int i = 0; i < 16; ++i) { kkn[i] = 0u; qfn[i] = 0u; }
        HG_LOAD_RAW(kk2, qf2, 0);
        for (int s = 0; s <= NCH; ++s) {
            HLAS unsigned char* img = lds + (s & 1) * IMG_BYTES;
            HLAS float* segtot = (HLAS float*)(aux0 + (s & 1) * AUX_BYTES); HLAS float* dec = segtot + 512;
            float bl0[16], bl1[16]; float a0 = 0.f, a1 = 0.f;
            if (s < NCH) {
                HG_DMA_V(s);
                if (s + 1 < NCH) HG_LOAD_RAW(kkn, qfn, s + 1);
        a0 = 0.f; a1 = 0.f;
#pragma unroll
        for (int i = 0; i < 16; ++i) { const float k0 = __uint_as_float(kk2[i] << 16), k1 = __uint_as_float(kk2[i] & 0xffff0000u);
            a0 += __builtin_amdgcn_logf(fmaxf(1.0f - k0, 1e-30f)); a1 += __builtin_amdgcn_logf(fmaxf(1.0f - k1, 1e-30f)); bl0[i] = a0; bl1[i] = a1; }
        *(HLAS f32x2_t*)(segtot + gw * 128 + 2 * lane) = (f32x2_t){a0, a1};
            }
            HG_BAR();
            if (s < NCH) {
        float p0 = 0.f, p1 = 0.f, t0 = 0.f, t1 = 0.f;
#pragma unroll
        for (int w = 0; w < 4; ++w) { const f32x2_t s = *(HLAS const f32x2_t*)(segtot + w * 128 + 2 * lane); if (w < gw) { p0 += s.x; p1 += s.y; } t0 += s.x; t1 += s.y; }
        const float ei0 = __builtin_amdgcn_exp2f(fminf(-t0, 115.f)), ei1 = __builtin_amdgcn_exp2f(fminf(-t1, 115.f));
        if (gw == 0) *(HLAS f32x2_t*)(dec + 2 * lane) = (f32x2_t){__builtin_amdgcn_exp2f(t0), __builtin_amdgcn_exp2f(t1)};
        {
            const int k = 2 * lane, k16 = k & 15, ng = (((k16 >> 2) & 1) << 1) | (k16 >> 3), pos = (k & ~15) + (ng << 2) + (k16 & 3);
            const unsigned chn = (unsigned)(k >> 3), bn = (unsigned)((k & 7) * 2), chp = (unsigned)(pos >> 3), bp = (unsigned)((pos & 7) * 2);
#pragma unroll
            for (int i = 0; i < 16; ++i) { const unsigned row = 16 * gw + i;
                const float k0 = __uint_as_float(kk2[i] << 16), k1 = __uint_as_float(kk2[i] & 0xffff0000u), q0 = __uint_as_float(qf2[i] << 16), q1 = __uint_as_float(qf2[i] & 0xffff0000u);
                const float e0 = __builtin_amdgcn_exp2f(p0 + bl0[i]), e1 = __builtin_amdgcn_exp2f(p1 + bl1[i]);
                const float l0 = fminf(fmaxf(e0 * ei0, 1e-30f), 1e30f), l1 = fminf(fmaxf(e1 * ei1, 1e-30f), 1e30f);
                *(HLAS unsigned*)(img + IMG_QT + off_b(row, chp) + bp) = cvtpk(q0 * e0, q1 * e1);
                *(HLAS unsigned*)(img + IMG_QP + off_b(row, chn) + bn) = cvtpk(q0 * l0, q1 * l1);
                *(HLAS unsigned*)(img + IMG_KH + off_b(row, chn) + bn) = cvtpk(k0 * __builtin_amdgcn_rcpf(l0), k1 * __builtin_amdgcn_rcpf(l1)); }
        }
                asm volatile("s_waitcnt vmcnt(0)" ::: "memory");
#pragma unroll
                for (int i = 0; i < 16; ++i) { kk2[i] = kkn[i]; qf2[i] = qfn[i]; }
            }
            HG_BAR();
        }
    } else {
        f32x16 S[4];
#pragma unroll
        for (int i = 0; i < 4; ++i) S[i] = f32x16{};
        u32x4 g16[4]; f32x16 o[2];
#pragma unroll
        for (int j = 0; j < 4; ++j) g16[j] = (u32x4){0u, 0u, 0u, 0u};
        o[0] = f32x16{}; o[1] = f32x16{};
        for (int s = 0; s <= NCH + 1; ++s) {
            if (s >= 2) { const int c = s - 2; HLAS float* OB = (HLAS float*)(lds + (c & 1) * IMG_BYTES);
        { const int t = gt >> 2, qd = gt & 3; f32x4 ov[8]; float ss = 0.f;
#pragma unroll
          for (int j = 0; j < 8; ++j) { ov[j] = *(HLAS const f32x4*)(OB + t * OB_PITCH + 32 * qd + 4 * j); ss += (ov[j][0] * ov[j][0] + ov[j][1] * ov[j][1]) + (ov[j][2] * ov[j][2] + ov[j][3] * ov[j][3]); }
          ss += __shfl_xor(ss, 1); ss += __shfl_xor(ss, 2);
          const float rs = 1.0f / sqrtf(ss * (1.0f / 128.0f) + 1e-6f);
          bf16_t* op = OC + (rowbase + (size_t)c * CH + t) * OPITCH + 512 + cb + 32 * qd;
#pragma unroll
          for (int j = 0; j < 4; ++j) { u32x4 w;
#pragma unroll
              for (int e = 0; e < 4; ++e) { const float ga = __uint_as_float(g16[j][e] << 16), gb = __uint_as_float(g16[j][e] & 0xffff0000u);
                  const int f = 2 * e; const f32x4 va = ov[2 * j + (f >> 2)];
                  w[e] = cvtpk(va[f & 3] * rs * ga, va[(f & 3) + 1] * rs * gb); }
              *(u32x4*)(op + 8 * j) = w; } }
            }
            if (s > NCH) break;
            HLAS unsigned char* img = lds + ((s - 1) & 1) * IMG_BYTES; HLAS float* dec = (HLAS float*)(aux0 + ((s - 1) & 1) * AUX_BYTES) + 512; HLAS float* OB = (HLAS float*)img;
            if (s >= 1) { const int c = s - 1;
        { const size_t r0 = rowbase + (size_t)c * CH + (gt >> 2);
#pragma unroll
          for (int j = 0; j < 4; ++j) g16[j] = *(const u32x4*)(GH + r0 * PITCH + cb + 32 * (gt & 3) + 8 * j); }
        o[0] = f32x16{}; o[1] = f32x16{};
#pragma unroll
        for (int kb = 0; kb < 4; ++kb) { const bf16x8 sb0 = pack8(S[kb], 0), sb1 = pack8(S[kb], 1);
#pragma unroll
            for (int tb = 0; tb < 2; ++tb) {
                const bf16x8 a0f = *(HLAS const bf16x8*)(img + IMG_QT + off_b(32 * tb + r32, 4 * kb + hh));
                const bf16x8 a1f = *(HLAS const bf16x8*)(img + IMG_QT + off_b(32 * tb + r32, 4 * kb + 2 + hh));
                o[tb] = HMFMA(a0f, sb0, o[tb]); o[tb] = HMFMA(a1f, sb1, o[tb]); }
            __builtin_amdgcn_sched_barrier(0); }
#pragma unroll
        for (int tb = 0; tb < 2; ++tb)
#pragma unroll
            for (int sb = 0; sb <= tb; ++sb) { f32x16 X = f32x16{};
#pragma unroll
                for (int ks = 0; ks < 8; ++ks) { const bf16x8 af = *(HLAS const bf16x8*)(img + IMG_KH + off_b(32 * sb + r32, 2 * ks + hh)), bf = *(HLAS const bf16x8*)(img + IMG_QP + off_b(32 * tb + r32, 2 * ks + hh));
                    X = HMFMA(af, bf, X); }
                if (sb == tb) {
#pragma unroll
                    for (int r = 0; r < 16; ++r) if (crow(r, hh) > r32) X[r] = 0.f; }
#pragma unroll
                for (int ss = 0; ss < 2; ++ss) { const bf16x8 xa = pack8(X, ss);
                    const unsigned rw = 32 * sb + 16 * ss + 4 * hh + tq;
                    const v4i16_t lo = trd(img + IMG_VV + off_v(rw, 4 * gw + 2 * blk + (tp >> 1)) + 8 * (tp & 1)), hi = trd(img + IMG_VV + off_v(rw + 8, 4 * gw + 2 * blk + (tp >> 1)) + 8 * (tp & 1));
                    const bf16x8 vb = (bf16x8){lo[0], lo[1], lo[2], lo[3], hi[0], hi[1], hi[2], hi[3]};
                    o[tb] = HMFMA(xa, vb, o[tb]); }
                __builtin_amdgcn_sched_barrier(0); }
#pragma unroll
        for (int kb = 0; kb < 4; ++kb)
#pragma unroll
            for (int g4 = 0; g4 < 4; ++g4) { const f32x4 d = *(HLAS const f32x4*)(dec + 32 * kb + 8 * g4 + 4 * hh);
#pragma unroll
                for (int e = 0; e < 4; ++e) S[kb][4 * g4 + e] *= d[e]; }
#pragma unroll
        for (int ss = 0; ss < 4; ++ss) { const unsigned rw = 16 * ss + 8 * hh + tq;
            const v4i16_t vlo = trd(img + IMG_VV + off_v(rw, 4 * gw + 2 * blk + (tp >> 1)) + 8 * (tp & 1)), vhi = trd(img + IMG_VV + off_v(rw + 4, 4 * gw + 2 * blk + (tp >> 1)) + 8 * (tp & 1));
            const bf16x8 vb = (bf16x8){vlo[0], vlo[1], vlo[2], vlo[3], vhi[0], vhi[1], vhi[2], vhi[3]};
#pragma unroll
            for (int kb = 0; kb < 4; ++kb) {
                const v4i16_t klo = trd(img + IMG_KH + off_b(rw, 4 * kb + 2 * blk + (tp >> 1)) + 8 * (tp & 1)), khi = trd(img + IMG_KH + off_b(rw + 4, 4 * kb + 2 * blk + (tp >> 1)) + 8 * (tp & 1));
                const bf16x8 ka = (bf16x8){klo[0], klo[1], klo[2], klo[3], khi[0], khi[1], khi[2], khi[3]};
                S[kb] = HMFMA(ka, vb, S[kb]); }
            __builtin_amdgcn_sched_barrier(0); }
            }
            HG_BAR();
            if (s >= 1) {
#pragma unroll
        for (int tb = 0; tb < 2; ++tb)
#pragma unroll
            for (int r = 0; r < 16; ++r) OB[(32 * tb + crow(r, hh)) * OB_PITCH + 32 * gw + r32] = o[tb][r];
            }
            HG_BAR();
        }
    }
    __syncthreads();
#undef HG_LOAD_RAW
#undef HG_DMA_V
}
#undef HMFMA
#undef HG_BAR
}
#define GAS __attribute__((address_space(1)))
#define LAS __attribute__((address_space(3)))
typedef unsigned short bf16;
typedef unsigned v4u __attribute__((ext_vector_type(4)));
typedef float f32x4 __attribute__((ext_vector_type(4)));
constexpr int T_ = 65536, D_ = 1024, FF_ = 2816, SEQ_ = 2048, NB_ = 32, NMOD_ = 9216, NMIX_ = 3584;
constexpr size_t MiB = 1u << 20;
constexpr size_t WS_CTL = 0, WS_MOD = 2 * MiB, WS_WFG = 4 * MiB, WS_LF = 5 * MiB, WS_SSQ = 7 * MiB, WS_FL2 = 9 * MiB - 0 * MiB;
constexpr size_t WS_W1IN = 12 * MiB, WS_W1OUT = 23 * MiB, WS_WMIX = 29 * MiB, WS_WOUT = 36 * MiB, WS_W2IN = 38 * MiB, WS_W2OUT = 49 * MiB;
constexpr size_t WS_XN = 64 * MiB, WS_H = 192 * MiB, WS_X2 = 640 * MiB, WS_XN2 = 896 * MiB, WS_END = 1024 * MiB;
constexpr size_t SEGSTRIDE = (size_t)T_ * 512;
static_assert(WS_FL2 + 2 * MiB <= WS_W1IN && WS_W2OUT + 6 * MiB <= WS_XN, "ws map");
constexpr int RING_BYTES = 131072, MISC_OFF = 2 * hg::IMG_BYTES, HG_AUX_OFF = MISC_OFF + 1024, LDS_BYTES = 147456;
static_assert(HG_AUX_OFF + 2 * hg::AUX_BYTES <= LDS_BYTES && attn_body::ATTN_LDS_BYTES <= RING_BYTES, "LDS map");
constexpr float LOG2E = 1.4426950408889634f;

struct Frame {
    LAS unsigned char* lds; volatile LAS unsigned* MISC;
    int tid, lane, wave, G;
    const float* in[19]; float* out; unsigned char* ws;
};
__device__ __forceinline__ float wave_sum(float v) {
#pragma unroll
    for (int o = 1; o < 64; o <<= 1) v += __shfl_xor(v, o);
    return v;
}
__device__ __forceinline__ unsigned f2bf(float f) { unsigned u = __builtin_bit_cast(unsigned, f); return (u + 0x7fffu + ((u >> 16) & 1u)) >> 16; }
__device__ __forceinline__ unsigned pk2(float lo, float hi) { return f2bf(lo) | (f2bf(hi) << 16); }
#define LDS_WAIT() asm volatile("s_waitcnt lgkmcnt(0)" ::: "memory")
#define XB_TMO      128
#define XB_XCNT(j)  (256  + 64 * (j))
#define XB_XSUB(j)  (1280 + 64 * (j))
#define XB_XGEN(j)  (2304 + 64 * (j))
#define XB_TOP      3328
#define XB_TOPGEN   3392
#define XCD_BAR_WORDS 3456
#define XB_SPIN_CAP (1u << 18)

__device__ __forceinline__ unsigned xb_ld(unsigned* p)              { return __hip_atomic_load(p, __ATOMIC_RELAXED, __HIP_MEMORY_SCOPE_AGENT); }
__device__ __forceinline__ unsigned xb_add(unsigned* p, unsigned v) { return __hip_atomic_fetch_add(p, v, __ATOMIC_RELAXED, __HIP_MEMORY_SCOPE_AGENT); }
__device__ __forceinline__ unsigned xb_xcc_id() { return (unsigned)__builtin_amdgcn_s_getreg((3 << 11) | 20) & 0xFu; }
#define XB_SPIN(cond, bar) do { unsigned _sp = 0; while (cond) { __builtin_amdgcn_s_sleep(1); \
    if ((++_sp & 255u) == 0u) { if (xb_ld(&(bar)[XB_TMO])) break; if (_sp > XB_SPIN_CAP) { atomicAdd(&(bar)[XB_TMO], 1u); break; } } } } while (0)

struct XcdBarrier {
    unsigned* bar; unsigned x;
    volatile LAS unsigned* st;
};

__device__ __forceinline__ XcdBarrier xcd_barrier_post(unsigned* bar, volatile LAS unsigned* st) {
    XcdBarrier b; b.bar = bar; b.x = xb_xcc_id(); b.st = st;
    if (threadIdx.x == 0) (void)xb_add(&bar[XB_XCNT(b.x)], 1u);
    return b;
}
__device__ __forceinline__ void xcd_barrier_complete(unsigned* bar, unsigned x, unsigned& nloc, unsigned& nx) {
    const unsigned G = gridDim.x * gridDim.y * gridDim.z;
    unsigned sum, cnt, mine, sp = 0u;
    for (;;) {
        sum = 0u; cnt = 0u; mine = 0u;
#pragma unroll
        for (unsigned j = 0; j < 16; ++j) { const unsigned c = xb_ld(&bar[XB_XCNT(j)]); sum += c; cnt += (c > 0u) ? 1u : 0u; mine = (j == x) ? c : mine; }
        if (sum == G) break;
        __builtin_amdgcn_s_sleep(1);
        if ((++sp & 255u) == 0u) { if (xb_ld(&bar[XB_TMO])) break; if (sp > XB_SPIN_CAP) { atomicAdd(&bar[XB_TMO], 1u); break; } }
    }
    nloc = mine > 0u ? mine : 1u; nx = cnt > 0u ? cnt : 1u;
}

__device__ __forceinline__ void xcd_barrier(const XcdBarrier& b) {
    asm volatile("s_waitcnt vmcnt(0)" ::: "memory");
    __syncthreads();
    if (threadIdx.x == 0) {
        unsigned* bar = b.bar;
        __builtin_amdgcn_s_waitcnt(0);
        unsigned nloc = b.st[0], nx = b.st[1];
        if (nloc == 0u) { xcd_barrier_complete(bar, b.x, nloc, nx); b.st[0] = nloc; b.st[1] = nx; }
        const unsigned old = xb_add(&bar[XB_XSUB(b.x)], 1u);
        const unsigned gen = old / nloc;
        if (old + 1u == (gen + 1u) * nloc) {
            __builtin_amdgcn_fence(__ATOMIC_RELEASE, "agent");
            asm volatile("s_waitcnt vmcnt(0)" ::: "memory");
            const unsigned og = xb_add(&bar[XB_TOP], 1u);
            const unsigned tg = og / nx;
            if (og + 1u == (tg + 1u) * nx) xb_add(&bar[XB_TOPGEN], 1u);
            else XB_SPIN(xb_ld(&bar[XB_TOPGEN]) == tg, bar);
            __builtin_amdgcn_fence(__ATOMIC_ACQUIRE, "agent");
            xb_add(&bar[XB_XGEN(b.x)], 1u);
            asm volatile("s_waitcnt vmcnt(0)" ::: "memory");
        } else {
            XB_SPIN(xb_ld(&bar[XB_XGEN(b.x)]) == gen, bar);
            __builtin_amdgcn_fence(__ATOMIC_ACQUIRE, "agent");
            asm volatile("s_waitcnt vmcnt(0)" ::: "memory");
        }
    }
    __syncthreads();
}

__device__ __forceinline__ void tr_item(const float* W, int ldw, int K, int k0, int n_src0, bf16* WT, int dst_row0, const float* ka, const float* kb, LAS float* scr, int lane) {
    float wv[32];
#pragma unroll
    for (int i = 0; i < 32; ++i) wv[i] = W[(size_t)(k0 + 2 * i + (lane >> 5)) * ldw + n_src0 + (lane & 31)];
#pragma unroll
    for (int i = 0; i < 32; ++i) { const int kk = 2 * i + (lane >> 5); float w = wv[i];
        if (ka) { const int k = k0 + kk; w *= (k < 512) ? ka[k] : kb[k - 512]; }
        scr[kk * 33 + (lane & 31)] = w; }
    LDS_WAIT(); asm volatile("" ::: "memory");
    const int c = lane & 7;
#pragma unroll
    for (int j = 0; j < 4; ++j) { const int n = (lane >> 3) + 8 * j; const LAS float* s = scr + (8 * c) * 33 + n;
        v4u o; o.x = pk2(s[0 * 33], s[1 * 33]); o.y = pk2(s[2 * 33], s[3 * 33]); o.z = pk2(s[4 * 33], s[5 * 33]); o.w = pk2(s[6 * 33], s[7 * 33]);
        *(v4u*)(WT + (size_t)(dst_row0 + n) * K + k0 + 8 * c) = o; }
    LDS_WAIT(); asm volatile("" ::: "memory");
}
__device__ __forceinline__ void p0_ffn_in_item(const float* W, bf16* WT, int r, LAS float* scr, int lane) {
    const int kb = r / 176, nb = r % 176, ns = 32 * nb; int dst;
    if (ns < FF_) dst = 256 * (ns / 128) + (ns % 128); else { const int c = ns - FF_; dst = 256 * (c / 128) + 128 + (c % 128); }
    tr_item(W, 2 * FF_, D_, 64 * kb, ns, WT, dst, nullptr, nullptr, scr, lane);
}
__device__ __forceinline__ void p0_mix_item(const float* W, bf16* WT, int r, LAS float* scr, int lane) {
    const int kb = r / 112, db = r % 112, seg = db >> 4, t = 32 * (db & 15), half = t >> 8, tt = t & 255;
    int feat = t; if (seg < 2) { const int bj = tt >> 7, wc = (tt & 127) >> 5; feat = 256 * half + 64 * wc + 32 * bj; }
    const int srcb = (seg < 3) ? 512 * seg : 1544 + 512 * (seg - 3);
    tr_item(W, 3592, D_, 64 * kb, srcb + feat, WT, 32 * db, nullptr, nullptr, scr, lane);
}
constexpr int P0_I_IN = 16 * 176, P0_I_OUT = 44 * 32, P0_I_MIX = 16 * 112, P0_I_WO = 16 * 32, P0_NITEMS = 2 * P0_I_IN + 2 * P0_I_OUT + P0_I_MIX + P0_I_WO;
__device__ __forceinline__ void p0_item(Frame& F, int it, LAS float* scr) {
    int r = it;
    if (r < P0_I_IN) { p0_ffn_in_item(F.in[5], (bf16*)(F.ws + WS_W1IN), r, scr, F.lane); return; } r -= P0_I_IN;
    if (r < P0_I_IN) { p0_ffn_in_item(F.in[17], (bf16*)(F.ws + WS_W2IN), r, scr, F.lane); return; } r -= P0_I_IN;
    if (r < P0_I_OUT) { tr_item(F.in[6], D_, FF_, 64 * (r / 32), 32 * (r % 32), (bf16*)(F.ws + WS_W1OUT), 32 * (r % 32), nullptr, nullptr, scr, F.lane); return; } r -= P0_I_OUT;
    if (r < P0_I_OUT) { tr_item(F.in[18], D_, FF_, 64 * (r / 32), 32 * (r % 32), (bf16*)(F.ws + WS_W2OUT), 32 * (r % 32), nullptr, nullptr, scr, F.lane); return; } r -= P0_I_OUT;
    if (r < P0_I_MIX) { p0_mix_item(F.in[8], (bf16*)(F.ws + WS_WMIX), r, scr, F.lane); return; } r -= P0_I_MIX;
    tr_item(F.in[15], D_, D_, 64 * (r / 32), 32 * (r % 32), (bf16*)(F.ws + WS_WOUT), 32 * (r % 32), F.in[12], F.in[14], scr, F.lane);
}
__device__ __forceinline__ void p0_prologue(Frame& F0) {
    Frame F = F0; { int t_ = threadIdx.x; asm volatile("" : "+v"(t_)); F.tid = t_; F.lane = t_ & 63; }
    float* mod = (float*)(F.ws + WS_MOD);
    for (int item = blockIdx.x; item < NMOD_ / 64; item += F.G) {
        LAS float* cs = (LAS float*)F.lds;
        for (int i = F.tid; i < NB_ * D_; i += 512) { const float c = F.in[1][i]; cs[i] = c / (1.0f + __expf(-c)); }
        __syncthreads();
        const int col = item * 64 + F.lane, k0 = F.wave * 128;
        float acc[32];
#pragma unroll
        for (int b = 0; b < 32; ++b) acc[b] = 0.f;
        const float* wp = F.in[2] + (size_t)k0 * NMOD_ + col;
#pragma unroll 1
        for (int k = 0; k < 128; k += 8) {
            float w[8];
#pragma unroll
            for (int j = 0; j < 8; ++j) w[j] = wp[(size_t)(k + j) * NMOD_];
#pragma unroll
            for (int b = 0; b < 32; ++b) { const f32x4 c4 = *(const LAS f32x4*)(cs + b * D_ + k0 + k); acc[b] += (c4[0] * w[0] + c4[1] * w[1]) + (c4[2] * w[2] + c4[3] * w[3]); }
            asm volatile("" ::: "memory");
#pragma unroll
            for (int b = 0; b < 32; ++b) { const f32x4 c4 = *(const LAS f32x4*)(cs + b * D_ + k0 + k + 4); acc[b] += (c4[0] * w[4] + c4[1] * w[5]) + (c4[2] * w[6] + c4[3] * w[7]); }
            asm volatile("" ::: "memory");
        }
        __syncthreads();
        LAS float* red = cs;
#pragma unroll
        for (int b = 0; b < 32; ++b) red[(F.wave * 32 + b) * 64 + F.lane] = acc[b];
        __syncthreads();
        for (int o = F.tid; o < 2048; o += 512) { const int b = o >> 6, l = o & 63; float s = 0.f;
#pragma unroll
            for (int w = 0; w < 8; ++w) s += red[(w * 32 + b) * 64 + l];
            mod[(size_t)b * NMOD_ + item * 64 + l] = s + F.in[3][item * 64 + l]; }
        __syncthreads();
    }
    { float* wfg = (float*)(F.ws + WS_WFG); const int gi = blockIdx.x * 512 + F.tid;
      for (int i = gi; i < 8 * D_; i += F.G * 512) wfg[i] = F.in[8][(size_t)(i & 1023) * 3592 + 1536 + (i >> 10)]; }
    LAS float* scr = (LAS float*)(F.lds + F.wave * 16384);
    const int gw = blockIdx.x * 8 + F.wave, NGW = F.G * 8;
    constexpr int NITEMS = P0_NITEMS, NA = 6912;
    if (F.G > NMOD_ / 64 + 16) {
        for (int it = gw; it < NA; it += NGW) p0_item(F, it, scr);
        if ((int)blockIdx.x >= NMOD_ / 64) { const int gw2 = ((int)blockIdx.x - NMOD_ / 64) * 8 + F.wave, NGW2 = (F.G - NMOD_ / 64) * 8;
            for (int it = NA + gw2; it < NITEMS; it += NGW2) p0_item(F, it, scr); }
    } else for (int it = gw; it < NITEMS; it += NGW) p0_item(F, it, scr);
}
template <bool SRCB> __device__ __forceinline__ f32x4 ld_row4(const float* src, size_t e) {
    if (!SRCB) return __builtin_nontemporal_load((const f32x4*)(src + e));
    const unsigned long long w = *(const unsigned long long*)((const bf16*)src + e); const unsigned lo = (unsigned)w, hi = (unsigned)(w >> 32);
    return (f32x4){__uint_as_float(lo << 16), __uint_as_float(lo & 0xffff0000u), __uint_as_float(hi << 16), __uint_as_float(hi & 0xffff0000u)};
}
template <int MODE, bool SRCB> __device__ __forceinline__ void norm_phase(Frame& F0, const float* src, const float* g, int sh_chunk, int sc_chunk) {
    Frame F = F0; { int t_ = threadIdx.x; asm volatile("" : "+v"(t_)); F.tid = t_; F.lane = t_ & 63; }
    const float* mod = (const float*)(F.ws + WS_MOD); bf16* XN = (bf16*)(F.ws + WS_XN);
    LAS float* wl = (LAS float*)F.lds;
    if (MODE == 1) { const float* wfg = (const float*)(F.ws + WS_WFG); for (int i = F.tid; i < 8 * D_; i += 512) wl[i] = wfg[i]; __syncthreads(); }
    const int gw = blockIdx.x * 8 + F.wave, NGW = F.G * 8;
    for (int r0 = gw * 32; r0 < T_; r0 += NGW * 32) {
        const int b = r0 / SEQ_; const float* mp = mod + (size_t)b * NMOD_;
        f32x4 A[4], Bv[4];
#pragma unroll
        for (int j = 0; j < 4; ++j) { const int col = 4 * F.lane + 256 * j; const f32x4 gg = *(const f32x4*)(g + col), sc = *(const f32x4*)(mp + sc_chunk * D_ + col);
            A[j] = gg * (sc + 1.0f); Bv[j] = *(const f32x4*)(mp + sh_chunk * D_ + col); }
        f32x4 nv[4];
#pragma unroll
        for (int j = 0; j < 4; ++j) nv[j] = ld_row4<SRCB>(src, (size_t)r0 * D_ + 4 * F.lane + 256 * j);
        for (int r = r0; r < r0 + 32; ++r) {
            f32x4 v[4]; float ss = 0.f;
#pragma unroll
            for (int j = 0; j < 4; ++j) { v[j] = nv[j]; ss += (v[j][0] * v[j][0] + v[j][1] * v[j][1]) + (v[j][2] * v[j][2] + v[j][3] * v[j][3]); }
            if (r + 1 < r0 + 32) {
#pragma unroll
                for (int j = 0; j < 4; ++j) nv[j] = ld_row4<SRCB>(src, (size_t)(r + 1) * D_ + 4 * F.lane + 256 * j); }
            const float rstd = 1.0f / sqrtf(wave_sum(ss) * (1.0f / D_) + 1e-6f);
#pragma unroll
            for (int j = 0; j < 4; ++j) { v[j] = v[j] * rstd * A[j] + Bv[j];
                *(unsigned long long*)(XN + (size_t)r * D_ + 4 * F.lane + 256 * j) = (unsigned long long)pk2(v[j][0], v[j][1]) | ((unsigned long long)pk2(v[j][2], v[j][3]) << 32); }
            if (MODE == 1) {
                float d[8];
#pragma unroll
                for (int h = 0; h < 8; ++h) { float s = 0.f;
#pragma unroll
                    for (int j = 0; j < 4; ++j) { const f32x4 w = *(const LAS f32x4*)(wl + h * D_ + 4 * F.lane + 256 * j); s += (v[j][0] * w[0] + v[j][1] * w[1]) + (v[j][2] * w[2] + v[j][3] * w[3]); }
                    d[h] = wave_sum(s); }
                float z = d[0];
#pragma unroll
                for (int h = 1; h < 8; ++h) z = (F.lane == h) ? d[h] : z;
                if (F.lane < 8) { z += F.in[9][F.lane]; ((float*)(F.ws + WS_LF))[(size_t)r * 8 + F.lane] = fminf(z, 0.f) - __logf(1.0f + __expf(-fabsf(z))); }
            }
        }
    }
    if (MODE == 1) __syncthreads();
}
__device__ __forceinline__ void fscan_phase(Frame& F0) {
    Frame F = F0; { int t_ = threadIdx.x; asm volatile("" : "+v"(t_)); F.tid = t_; F.lane = t_ & 63; }
    const float* LF = (const float*)(F.ws + WS_LF); float* FL2 = (float*)(F.ws + WS_FL2);
    LAS float* wsum = (LAS float*)F.lds;
    for (int bh = blockIdx.x; bh < 256; bh += F.G) { const int b = bh >> 3, h = bh & 7;
        float p[4]; float a = 0.f;
#pragma unroll
        for (int i = 0; i < 4; ++i) { a += LF[((size_t)b * SEQ_ + 4 * F.tid + i) * 8 + h]; p[i] = a; }
        float incl = a;
#pragma unroll
        for (int o = 1; o < 64; o <<= 1) { const float t = __shfl_up(incl, o); if (F.lane >= o) incl += t; }
        if (F.lane == 63) wsum[F.wave] = incl;
        __syncthreads();
        float woff = 0.f;
#pragma unroll
        for (int w = 0; w < 8; ++w) woff += (w < F.wave) ? wsum[w] : 0.f;
        const float ex = woff + incl - a;
        f32x4 o4; o4[0] = (ex + p[0]) * LOG2E; o4[1] = (ex + p[1]) * LOG2E; o4[2] = (ex + p[2]) * LOG2E; o4[3] = (ex + p[3]) * LOG2E;
        *(f32x4*)(FL2 + (size_t)bh * SEQ_ + 4 * F.tid) = o4;
        __syncthreads();
    }
}

#ifndef PHASE_MASK
#define PHASE_MASK 0x7ff
#endif
#ifndef P6SEL
#define P6SEL 0
#endif
#ifndef REPEAT_MASK
#define REPEAT_MASK 0
#endif
#define PH(k) if constexpr (((PHASE_MASK) >> (k)) & 1) for (int rep_ = 0; rep_ < 1 + (((REPEAT_MASK) >> (k)) & 1); ++rep_)
struct Args { const float* in[19]; float* out; unsigned char* ws; int pad0, pad1; };
__global__ void __launch_bounds__(512, 2) fwd_mega(Args args) {
    extern __shared__ __attribute__((aligned(16))) unsigned char lds[];
    cg::grid_group grid = cg::this_grid();
    Frame F;
    F.lds = (LAS unsigned char*)lds; F.MISC = (volatile LAS unsigned*)(F.lds + MISC_OFF);
    F.tid = threadIdx.x; F.lane = F.tid & 63; F.wave = __builtin_amdgcn_readfirstlane(F.tid >> 6); F.G = gridDim.x;
#pragma unroll
    for (int i = 0; i < 19; ++i) F.in[i] = args.in[i];
    F.out = args.out; F.ws = args.ws;
    unsigned char* ws = args.ws;
    float* mod = (float*)(ws + WS_MOD);
    bf16* XN = (bf16*)(ws + WS_XN); bf16* HB = (bf16*)(ws + WS_H); bf16* PJ = (bf16*)(ws + WS_H); float* X2 = (float*)(ws + WS_X2);
    const int bid = (int)blockIdx.x;
    if (threadIdx.x < 16) F.MISC[threadIdx.x] = 0u;
    __syncthreads();
    const XcdBarrier xbar = xcd_barrier_post((unsigned*)(ws + WS_CTL + 16384), F.MISC + 8);
#define GSYNC() xcd_barrier(xbar)

    PH(0) p0_prologue(F);
    grid.sync();
#ifdef SYNC_PROBE
    for (int i_ = 0; i_ < 20; ++i_) grid.sync();
#endif
    PH(1) norm_phase<0, false>(F, F.in[0], F.in[4], 0, 1);
    GSYNC();
    PH(2) { pg8::Gemm g{XN, (const bf16*)(ws + WS_W1IN), T_, 2 * FF_, D_}; pg8::StaticOrder S; S.init(T_, 2 * FF_, F.G, bid);
      pg8::EpiSwiGLU E{HB, FF_};
      pg8::gemm_phase<pg8::EpiSwiGLU, pg8::StaticOrder, true, true>(F.lds, g, S, E); }
    GSYNC();
    PH(3) { pg8::Gemm g{HB, (const bf16*)(ws + WS_W1OUT), T_, D_, FF_, 1}; pg8::StaticOrder S; S.init(T_, D_, F.G, bid);
      pg8::EpiResid<false> E{F.in[0], F.out, mod + 2 * D_, 0.5f, nullptr};
      pg8::gemm_phase<pg8::EpiResid<false>, pg8::StaticOrder, true, true>(F.lds, g, S, E); }
    GSYNC();
    PH(4) norm_phase<1, false>(F, F.out, F.in[7], 3, 4);
    GSYNC();
    PH(5) fscan_phase(F);
    PH(5) { pg8::Gemm g{XN, (const bf16*)(ws + WS_WMIX), T_, NMIX_, D_}; pg8::StaticOrder S; S.init(T_, NMIX_, F.G, bid);
      pg8::EpiMix E{PJ, SEGSTRIDE, F.in[10], F.in[11], F.in[13], attn_body::C2};
      pg8::gemm_phase<pg8::EpiMix, pg8::StaticOrder, true, true>(F.lds, g, S, E); }
    GSYNC();
    PH(6) {
        const int xl = bid & 7;
        unsigned* q = (unsigned*)(ws + WS_CTL) + 1024 * rep_ + 64 * xl;
        const attn_body::bf16* Qp = (const attn_body::bf16*)PJ; const attn_body::bf16* Kp = Qp + SEGSTRIDE; const attn_body::bf16* Vp = Qp + 2 * SEGSTRIDE;
        for (;;) {
            if (threadIdx.x == 0) F.MISC[0] = atomicAdd(q, 1u);
            __syncthreads();
            const int idx = (int)F.MISC[0];
            __syncthreads();
            if (idx >= 16 + 256) break;
            if (idx < 16) { if (!(rep_ == 1 && P6SEL >= 2)) hg::hgrn_unit(xl + 8 * idx, PJ + 3 * SEGSTRIDE, PJ + 4 * SEGSTRIDE, PJ + 5 * SEGSTRIDE, PJ + 6 * SEGSTRIDE, XN, F.lds, F.lds + HG_AUX_OFF); }
            else if (!(rep_ == 1 && P6SEL == 1)) { const int a = idx - 16, bh = xl + 8 * (a & 31), qb = 7 - (a >> 5);
                const float* Fg = (const float*)(ws + WS_FL2) + (size_t)bh * SEQ_;
                attn_body::attn_unit<90, true>(bh >> 3, bh & 7, qb, Qp, Kp, Vp, (attn_body::bf16*)XN, Fg, (float*)(ws + WS_SSQ), (char*)lds); }
        }
    }
    GSYNC();
    PH(7) { pg8::Gemm g{XN, (const bf16*)(ws + WS_WOUT), T_, D_, D_}; pg8::StaticOrder S; S.init(T_, D_, F.G, bid);
      typedef pg8::EpiResidNorm<true> EN; static_assert(EN::O_MOD == WS_MOD && EN::O_LF == WS_LF && EN::O_SSQ == WS_SSQ && EN::O_XN2 == WS_XN2 && EN::O_CNT == WS_CTL + 65536, "fused-norm epilogue vs the workspace map");
      pg8::EpiResidNorm<true> E{F.out, X2, ws, F.in[16], 1.0f};
      pg8::gemm_phase<pg8::EpiResidNorm<true>, pg8::StaticOrder, true, true>(F.lds, g, S, E); }
    GSYNC();
    PH(9) { pg8::Gemm g{(const bf16*)(ws + WS_XN2), (const bf16*)(ws + WS_W2IN), T_, 2 * FF_, D_}; pg8::StaticOrder S; S.init(T_, 2 * FF_, F.G, bid);
      pg8::EpiSwiGLU E{HB, FF_};
      pg8::gemm_phase<pg8::EpiSwiGLU, pg8::StaticOrder, true, true>(F.lds, g, S, E); }
    GSYNC();
    PH(10) { pg8::Gemm g{HB, (const bf16*)(ws + WS_W2OUT), T_, D_, FF_, 1}; pg8::StaticOrder S; S.init(T_, D_, F.G, bid);
      pg8::EpiResid<false> E{X2, F.out, mod + 8 * D_, 0.5f, nullptr};
      pg8::gemm_phase<pg8::EpiResid<false>, pg8::StaticOrder, true, true>(F.lds, g, S, E); }
}

extern "C" void kernel_launch(void* const* d_in, const int* in_sizes, int n_in, void* d_out, int out_size, void* d_ws, size_t ws_size, hipStream_t stream) {
    static int grid = 0;
    if (grid == 0) {
        int dev = 0, cus = 0, per_cu = 0;
        if (n_in != 19 || out_size != T_ * D_ || ws_size < WS_END) { fprintf(stderr, "kernel_launch: unexpected shapes (n_in %d out %d ws %zu)\n", n_in, out_size, ws_size); grid = -1; return; }
        (void)hipGetDevice(&dev);
        (void)hipDeviceGetAttribute(&cus, hipDeviceAttributeMultiprocessorCount, dev);
        (void)hipFuncSetAttribute((const void*)fwd_mega, hipFuncAttributeMaxDynamicSharedMemorySize, LDS_BYTES);
        (void)hipOccupancyMaxActiveBlocksPerMultiprocessor(&per_cu, (const void*)fwd_mega, 512, LDS_BYTES);
        (void)hipGetLastError();
        grid = cus > 0 ? cus : 256;
        fprintf(stderr, "kernel_launch: cus %d per_cu %d grid %d ws %zu\n", cus, per_cu, grid, ws_size);
    }
    if (grid < 0) return;
    (void)hipMemsetAsync((char*)d_ws + WS_CTL, 0, 131072, stream);
    Args a{};
    for (int i = 0; i < 19; ++i) a.in[i] = (const float*)d_in[i];
    a.out = (float*)d_out; a.ws = (unsigned char*)d_ws;
    void* args[] = {&a};
    hipError_t e = hipLaunchCooperativeKernel((const void*)fwd_mega, dim3(grid), dim3(512), args, LDS_BYTES, stream);
    if (e != hipSuccess) fprintf(stderr, "cooperative launch failed: %s (grid %d)\n", hipGetErrorString(e), grid);
}
```
